# Optimizing an MI355X kernel written in HIP

```python
import jax
import jax.numpy as jnp
from jax import lax
import numpy as np

D_MODEL = 1024
BATCH = 8
SEQ = 4096
DEPTH = 2

MEM_LEN = 256
GRID_W = 64
EPS = 1e-6
NEG_INF = -1e30
HEAD_DIM = 64
D_FF = 11 * D_MODEL // 4
CONV_CH = D_MODEL // 4
CONV_WIDTH = 31
WIN_HEADS = (D_MODEL // 2) // HEAD_DIM
WIN_KV_HEADS = 2
WIN_GROUP = WIN_HEADS // WIN_KV_HEADS
WINDOW = 128
BLOCK = 128
T5_BUCKETS = 32
T5_MAX_DIST = 128
NA_HEADS = (D_MODEL // 4) // HEAD_DIM
NA_ROWS_MAX = 8
NA_COLS = 16
X_HEADS = 4
X_HEAD_DIM = D_MODEL // X_HEADS
N_BRANCH = 3
IN_WIDTHS = (2 * CONV_CH,
             WIN_HEADS * HEAD_DIM, WIN_KV_HEADS * HEAD_DIM, WIN_KV_HEADS * HEAD_DIM,
             NA_HEADS * HEAD_DIM, NA_HEADS * HEAD_DIM, NA_HEADS * HEAD_DIM,
             N_BRANCH * D_MODEL)
IN_WIDTH = sum(IN_WIDTHS)
IN_SPLITS = tuple(sum(IN_WIDTHS[:i + 1]) for i in range(len(IN_WIDTHS) - 1))

kernel_name = 'hybrid_conv_window_natten_encoder'


def rms_norm(x, g):
    xf = x.astype(jnp.float32)
    y = xf * lax.rsqrt(jnp.mean(xf * xf, axis=-1, keepdims=True) + EPS)
    return (y * g.astype(jnp.float32)).astype(x.dtype)


def layer_norm(x, g, b):
    xf = x.astype(jnp.float32)
    mu = jnp.mean(xf, axis=-1, keepdims=True)
    var = jnp.mean(jnp.square(xf - mu), axis=-1, keepdims=True)
    y = (xf - mu) * lax.rsqrt(var + EPS)
    return (y * g.astype(jnp.float32) + b.astype(jnp.float32)).astype(x.dtype)


def swiglu(x, w_gate, w_up, w_down):
    return (jax.nn.silu(x @ w_gate) * (x @ w_up)) @ w_down


def conformer_conv(u, dw_w, dw_b, ln_g, ln_b):
    a, gate = jnp.split(u, 2, axis=-1)
    z = a * jax.nn.sigmoid(gate)
    z = lax.conv_general_dilated(
        z, dw_w[:, None, :].astype(z.dtype), window_strides=(1,),
        padding=((CONV_WIDTH // 2, CONV_WIDTH // 2),),
        dimension_numbers=('NWC', 'WIO', 'NWC'),
        feature_group_count=CONV_CH) + dw_b
    z = layer_norm(z, ln_g, ln_b)
    return jax.nn.silu(z)


def t5_buckets(rel):
    half = T5_BUCKETS // 2
    max_exact = half // 2
    ret = (rel > 0).astype(np.int32) * half
    n = np.abs(rel)
    large = max_exact + (np.log(np.maximum(n, 1) / max_exact)
                         / np.log(T5_MAX_DIST / max_exact) * (half - max_exact)).astype(np.int32)
    large = np.minimum(large, half - 1)
    return ret + np.where(n < max_exact, n, large)


def windowed_gqa(q, k, v, sink, t5_table):
    bsz, seq = q.shape[0], q.shape[1]
    nblk = seq // BLOCK
    span = BLOCK + 2 * WINDOW
    rel = np.arange(span)[None, :] - WINDOW - np.arange(BLOCK)[:, None]
    band = np.abs(rel) <= WINDOW
    bias = jnp.transpose(t5_table[t5_buckets(rel)], (2, 0, 1)).astype(jnp.float32)
    bias = bias.reshape(WIN_KV_HEADS, WIN_GROUP, BLOCK, span)
    sink_g = sink.astype(jnp.float32).reshape(WIN_KV_HEADS, WIN_GROUP)[:, :, None, None]
    kp = jnp.pad(k, ((0, 0), (WINDOW, WINDOW), (0, 0), (0, 0)))
    vp = jnp.pad(v, ((0, 0), (WINDOW, WINDOW), (0, 0), (0, 0)))
    scale = HEAD_DIM ** -0.5

    def one_block(i):
        start = i * BLOCK
        qb = lax.dynamic_slice_in_dim(q, start, BLOCK, axis=1)
        kb = lax.dynamic_slice_in_dim(kp, start, span, axis=1)
        vb = lax.dynamic_slice_in_dim(vp, start, span, axis=1)
        s = jnp.einsum('bqkgd,bskd->bkgqs', qb, kb).astype(jnp.float32) * scale + bias
        kpos = start - WINDOW + jnp.arange(span)
        valid = jnp.logical_and(band, ((kpos >= 0) & (kpos < seq))[None, :])
        s = jnp.where(valid, s, NEG_INF)
        m = jnp.maximum(jnp.max(s, axis=-1, keepdims=True), sink_g)
        p = jnp.exp(s - m)
        p = p / (jnp.sum(p, axis=-1, keepdims=True) + jnp.exp(sink_g - m))
        o = jnp.einsum('bkgqs,bskd->bqkgd', p.astype(vb.dtype), vb)
        return o.reshape(bsz, BLOCK, WIN_HEADS * HEAD_DIM)

    out = lax.map(one_block, jnp.arange(nblk))
    return jnp.transpose(out, (1, 0, 2, 3)).reshape(bsz, seq, WIN_HEADS * HEAD_DIM)


def neighbourhood_attn(q, k, v, rpb):
    bsz, seq = q.shape[0], q.shape[1]
    rows = seq // GRID_W
    wr = min(NA_ROWS_MAX, rows)
    qg = q.reshape(bsz, rows, GRID_W, NA_HEADS, HEAD_DIM)
    kg = k.reshape(bsz, rows, GRID_W, NA_HEADS, HEAD_DIM)
    vg = v.reshape(bsz, rows, GRID_W, NA_HEADS, HEAD_DIM)
    col = np.arange(GRID_W)
    col_start = np.clip(col - NA_COLS // 2, 0, GRID_W - NA_COLS)
    col_idx = col_start[:, None] + np.arange(NA_COLS)[None, :]
    dcol = col_idx - col[:, None]
    rpb_c = rpb[:, :, dcol + NA_COLS - 1].astype(jnp.float32)
    scale = HEAD_DIM ** -0.5

    def one_row(r):
        rs = jnp.clip(r - wr // 2, 0, rows - wr)
        qr = lax.dynamic_index_in_dim(qg, r, axis=1, keepdims=False)
        kr = lax.dynamic_slice_in_dim(kg, rs, wr, axis=1)
        vr = lax.dynamic_slice_in_dim(vg, rs, wr, axis=1)
        kn = kr[:, :, col_idx]
        vn = vr[:, :, col_idx]
        drow = rs + jnp.arange(wr) - r
        bias = jnp.transpose(rpb_c[:, drow + NA_ROWS_MAX - 1], (0, 2, 1, 3))
        s = jnp.einsum('bchd,bwcjhd->bhcwj', qr, kn).astype(jnp.float32) * scale + bias
        p = jax.nn.softmax(s.reshape(bsz, NA_HEADS, GRID_W, wr * NA_COLS), axis=-1)
        p = p.reshape(bsz, NA_HEADS, GRID_W, wr, NA_COLS)
        o = jnp.einsum('bhcwj,bwcjhd->bchd', p.astype(vn.dtype), vn)
        return o.reshape(bsz, GRID_W, NA_HEADS * HEAD_DIM)

    out = lax.map(one_row, jnp.arange(rows))
    return jnp.transpose(out, (1, 0, 2, 3)).reshape(bsz, seq, NA_HEADS * HEAD_DIM)


def memory_cross_attn(h, mem_n, w_q, w_kv, w_o):
    bsz, seq = h.shape[0], h.shape[1]
    q = (h @ w_q).reshape(bsz, seq, X_HEADS, X_HEAD_DIM)
    k, v = jnp.split(mem_n @ w_kv, 2, axis=-1)
    k = k.reshape(bsz, -1, X_HEADS, X_HEAD_DIM)
    v = v.reshape(bsz, -1, X_HEADS, X_HEAD_DIM)
    s = jnp.einsum('bqhd,bmhd->bhqm', q, k).astype(jnp.float32) * (X_HEAD_DIM ** -0.5)
    p = jax.nn.softmax(s, axis=-1)
    o = jnp.einsum('bhqm,bmhd->bqhd', p.astype(v.dtype), v)
    return o.reshape(bsz, seq, X_HEADS * X_HEAD_DIM) @ w_o


def setup_inputs(seed: int = 0) -> dict:
    key = jax.random.key(seed)
    keys = iter(jax.random.split(key, 64))
    f32 = jnp.float32

    def w(shape, fan_in):
        return jax.random.normal(next(keys), shape, f32) * fan_in ** -0.5

    def gain(shape):
        return 1.0 + 0.02 * jax.random.normal(next(keys), shape, f32)

    def small(shape, s):
        return s * jax.random.normal(next(keys), shape, f32)

    L, D = DEPTH, D_MODEL
    return {
        'x': jax.random.normal(next(keys), (BATCH, SEQ, D), f32),
        'mem': jax.random.normal(next(keys), (BATCH, MEM_LEN, D), f32),
        'norm_ffn1': gain((L, D)),
        'ffn1_w_gate': w((L, D, D_FF), D),
        'ffn1_w_up': w((L, D, D_FF), D),
        'ffn1_w_down': w((L, D_FF, D), D_FF),
        'norm_mix': gain((L, D)),
        'w_in': w((L, D, IN_WIDTH), D),
        'conv_dw_w': w((L, CONV_WIDTH, CONV_CH), CONV_WIDTH),
        'conv_dw_b': small((L, CONV_CH), 0.02),
        'conv_ln_g': gain((L, CONV_CH)),
        'conv_ln_b': small((L, CONV_CH), 0.02),
        'conv_w_out': w((L, CONV_CH, D), CONV_CH),
        'win_sink': small((L, WIN_HEADS), 0.5),
        't5_bias': small((T5_BUCKETS, WIN_HEADS), 0.1),
        'win_w_out': w((L, WIN_HEADS * HEAD_DIM, D), WIN_HEADS * HEAD_DIM),
        'na_rpb': small((L, NA_HEADS, 2 * NA_ROWS_MAX - 1, 2 * NA_COLS - 1), 0.1),
        'na_w_out': w((L, NA_HEADS * HEAD_DIM, D), NA_HEADS * HEAD_DIM),
        'w_out': w((L, D, D), D),
        'norm_cross': gain((L, D)),
        'norm_mem': gain((L, D)),
        'cross_w_q': w((L, D, X_HEADS * X_HEAD_DIM), D),
        'cross_w_kv': w((L, D, 2 * X_HEADS * X_HEAD_DIM), D),
        'cross_w_o': w((L, X_HEADS * X_HEAD_DIM, D), X_HEADS * X_HEAD_DIM),
        'norm_ffn2': gain((L, D)),
        'ffn2_w_gate': w((L, D, D_FF), D),
        'ffn2_w_up': w((L, D, D_FF), D),
        'ffn2_w_down': w((L, D_FF, D), D_FF),
        'norm_final': gain((D,)),
    }


def reference(x, mem, norm_ffn1, ffn1_w_gate, ffn1_w_up, ffn1_w_down, norm_mix, w_in,
              conv_dw_w, conv_dw_b, conv_ln_g, conv_ln_b, conv_w_out, win_sink, t5_bias,
              win_w_out, na_rpb, na_w_out, w_out, norm_cross, norm_mem, cross_w_q,
              cross_w_kv, cross_w_o, norm_ffn2, ffn2_w_gate, ffn2_w_up, ffn2_w_down,
              norm_final):
    bsz, seq, _ = x.shape
    for l in range(DEPTH):
        x = x + 0.5 * swiglu(rms_norm(x, norm_ffn1[l]), ffn1_w_gate[l], ffn1_w_up[l], ffn1_w_down[l])
        h = rms_norm(x, norm_mix[l])
        u_a, bq, bk, bv, cq, ck, cv, gates = jnp.split(h @ w_in[l], IN_SPLITS, axis=-1)
        y_a = conformer_conv(u_a, conv_dw_w[l], conv_dw_b[l], conv_ln_g[l], conv_ln_b[l]) @ conv_w_out[l]
        y_b = windowed_gqa(
            bq.reshape(bsz, seq, WIN_KV_HEADS, WIN_GROUP, HEAD_DIM),
            bk.reshape(bsz, seq, WIN_KV_HEADS, HEAD_DIM),
            bv.reshape(bsz, seq, WIN_KV_HEADS, HEAD_DIM),
            win_sink[l], t5_bias) @ win_w_out[l]
        y_c = neighbourhood_attn(
            cq.reshape(bsz, seq, NA_HEADS, HEAD_DIM),
            ck.reshape(bsz, seq, NA_HEADS, HEAD_DIM),
            cv.reshape(bsz, seq, NA_HEADS, HEAD_DIM),
            na_rpb[l]) @ na_w_out[l]
        g = jax.nn.sigmoid(gates).reshape(bsz, seq, N_BRANCH, D_MODEL)
        y = g[:, :, 0] * y_a + g[:, :, 1] * y_b + g[:, :, 2] * y_c
        x = x + y @ w_out[l]
        x = x + memory_cross_attn(rms_norm(x, norm_cross[l]), rms_norm(mem, norm_mem[l]),
                                  cross_w_q[l], cross_w_kv[l], cross_w_o[l])
        x = x + 0.5 * swiglu(rms_norm(x, norm_ffn2[l]), ffn2_w_gate[l], ffn2_w_up[l], ffn2_w_down[l])
    return rms_norm(x, norm_final)
```

```cpp
#include <hip/hip_runtime.h>
#include <hip/hip_cooperative_groups.h>
#include <cstdio>
#include <cstdint>
#include <type_traits>
namespace cg = cooperative_groups;

#ifndef REP_Y
#define REP_Y 1
#endif
#ifndef REP_P0
#define REP_P0 1
#endif
#ifndef REP_UP
#define REP_UP 1
#endif
#ifndef REP_MIX
#define REP_MIX 1
#endif
#ifndef REP_CROSS
#define REP_CROSS 1
#endif
#ifndef REP_NORM
#define REP_NORM 1
#endif
#define DI __device__ __forceinline__
#define LAS __attribute__((address_space(3)))
typedef unsigned short bf16_t;
typedef short bf16x8 __attribute__((ext_vector_type(8)));
typedef float f32x4 __attribute__((ext_vector_type(4)));
typedef float f32x16 __attribute__((ext_vector_type(16)));
typedef unsigned u32x4 __attribute__((ext_vector_type(4)));
typedef unsigned u32x2 __attribute__((ext_vector_type(2)));

constexpr int D = 1024, BATCH = 8, SEQ = 4096, M = BATCH * SEQ, DEPTH = 2, MEMLEN = 256, DFF = 2816, NGU = 2 * DFF, NIN = 5120;
constexpr int UP = 1024;
constexpr int UC_Z = 0, UC_BQ = 256, UC_CQ = 768;
constexpr float EPS = 1e-6f, LOG2E = 1.4426950408889634f;

constexpr size_t MiB = 1u << 20;
constexpr size_t WO_1GU = 0, WO_1D = WO_1GU + (size_t)NGU * D, WO_IN = WO_1D + (size_t)D * DFF, WO_CO = WO_IN + (size_t)NIN * D,
                 WO_WO = WO_CO + (size_t)D * 256, WO_NO = WO_WO + (size_t)D * 512, WO_OUT = WO_NO + (size_t)D * 256, WO_CQ = WO_OUT + (size_t)D * D,
                 WO_CKV = WO_CQ + (size_t)D * D, WO_COO = WO_CKV + (size_t)2 * D * D, WO_2GU = WO_COO + (size_t)D * D, WO_2D = WO_2GU + (size_t)NGU * D,
                 W_LAYER = WO_2D + (size_t)D * DFF;
static_assert(W_LAYER * 2 * DEPTH == 110 * MiB, "weights");
constexpr size_t WS_W = 1 * MiB, WS_KX = 111 * MiB, WS_VXT = 119 * MiB, WS_VTB = 127 * MiB, WS_VTC = 135 * MiB, WS_XB = 151 * MiB, WS_U = 215 * MiB,
                 WS_END = WS_U + 280 * MiB;
static_assert(WS_END == 495 * MiB && (size_t)M * UP * 2 <= 64 * MiB, "ws map");
constexpr size_t WS_MEMN = WS_U + 200 * MiB;
constexpr size_t WS_QX = WS_U, WS_OX = WS_U + 64 * MiB;
constexpr size_t WS_VFB = WS_U + 64 * MiB, WS_VFC = WS_U + 72 * MiB;
constexpr size_t WS_Y = WS_U;
constexpr size_t WS_G = WS_U + 88 * MiB;
constexpr size_t WS_SS = 496 * MiB;
constexpr size_t WS_NEED = WS_SS + (size_t)9 * M * 8;
typedef unsigned long long u64;
constexpr float SS_SCALE = 262144.f, SS_INV = 1.f / (262144.f * 1024.f);

DI unsigned pk2(float lo, float hi) {
    typedef float f2 __attribute__((ext_vector_type(2))); typedef __bf16 b2 __attribute__((ext_vector_type(2)));
    f2 v = {lo, hi}; b2 b = __builtin_convertvector(v, b2); return __builtin_bit_cast(unsigned, b);
}
DI float bflo(unsigned w) { return __uint_as_float(w << 16); }
DI float bfhi(unsigned w) { return __uint_as_float(w & 0xffff0000u); }
DI float einv(float x) { return fminf(1.f + __builtin_amdgcn_exp2f(-LOG2E * x), 1.0e30f); }
DI float sigm(float x) { return __builtin_amdgcn_rcpf(1.f + __builtin_amdgcn_exp2f(-LOG2E * x)); }
DI int tslot(int fr) { return ((fr >> 2) & 1) * 8 + (fr >> 3) * 4 + (fr & 3); }

namespace pg8 {
constexpr int BM = 256, BK = 64, HALF = 128, HTB = HALF * BK * 2, STAGE_BYTES = 8 * HTB, NXCD = 8, WGM = 4;
__host__ __device__ __forceinline__ int lds_byte(int r, int c) { const int st = (r >> 4) * 2 + (c >> 5), rr = r & 15, cc = c & 31, ob = rr * 64 + cc * 2; return st * 1024 + (ob ^ (((ob >> 9) & 1) << 5)); }
__host__ __device__ __forceinline__ void stage_rc(int b, int& R, int& C) { const int st = b / 1024, sb = b % 1024, swz = sb ^ (((sb >> 9) & 1) << 5); R = (st >> 1) * 16 + swz / 64; C = (st & 1) * 32 + (swz % 64) / 2; }
__host__ __device__ __forceinline__ int perm32(int rho) { const int n = rho >> 4, i = rho & 15; return 8 * (i >> 2) + 4 * n + (i & 3); }

struct Unit { int pm, pn; };
struct Gemm { const bf16_t* A; const bf16_t* Bt; int lda, ldb, K; size_t bsB = 0; };
struct StaticOrder {
    int nM, nN, nwg, G, c;
    DI void init(int M_, int N_, int G_, int c_) { nM = M_ / BM; nN = N_ / BM; nwg = nM * nN; G = G_; c = c_; }
    DI bool next(int i, Unit& u) const {
        const long L = (long)i * G + c; if (L >= nwg) return false;
        int wgid = (int)L; { const int q = nwg / NXCD, r = nwg % NXCD, xcd = wgid % NXCD, off = wgid / NXCD; wgid = (xcd < r ? xcd * (q + 1) : r * (q + 1) + (xcd - r) * q) + off; }
        const int nig = WGM * nN, gid = wgid / nig, fm = gid * WGM, gsz = (nM - fm) < WGM ? (nM - fm) : WGM;
        u.pm = fm + ((wgid % nig) % gsz); u.pn = (wgid % nig) / gsz; return true;
    }
};

template <class Epi, bool ALIGN_EPI>
DI void gemm_phase(LAS unsigned char* lds, const Gemm g, const StaticOrder& S, const Epi& E) {
    int tid = threadIdx.x; asm volatile("" : "+v"(tid));
    const int wid = __builtin_amdgcn_readfirstlane(tid >> 6), lane = tid & 63, wr = wid >> 2, wc = wid & 3, fr = lane & 15, fq = lane >> 4;
    const int K = g.K, nt = K / BK;
    unsigned voffA[2], voffB[2];
#pragma unroll
    for (int i = 0; i < 2; ++i) { int R, C; stage_rc(tid * 16 + i * 8192, R, C); const int Rb = Epi::PERM ? ((R & ~31) + perm32(R & 31)) : R;
        voffA[i] = (unsigned)(R * g.lda + C) * 2u; voffB[i] = (unsigned)(Rb * g.ldb + C) * 2u; }
    const size_t kstep = (size_t)(BK * 2);
    const size_t hstepA = (size_t)HALF * g.lda * 2, hstepB = (size_t)HALF * g.ldb * 2;
    const size_t tstepA = 2 * hstepA, tstepB = 2 * hstepB;
    const unsigned ldsw = (unsigned)wid * 1024u;
    const int aoff = lds_byte(wr * 64 + fr, fq * 8), boff = lds_byte(wc * 32 + fr, fq * 8);
#define PG8_SA(b, h) (((b) * 2 + (h)) * HTB)
#define PG8_SB(b, h) ((4 + (b) * 2 + (h)) * HTB)
#define PG8_STAGE(bufoff, gbase, voff) do { _Pragma("unroll") for (int _i = 0; _i < 2; ++_i) \
        __builtin_amdgcn_global_load_lds((const unsigned*)((const char*)(gbase) + (voff)[_i]), (LAS unsigned*)(lds + (bufoff) + ldsw + _i * 8192), 16, 0, 0); } while (0)
#define PG8_LDA(dst, b, h) do { _Pragma("unroll") for (int m = 0; m < 4; ++m) _Pragma("unroll") for (int k = 0; k < 2; ++k) dst[m][k] = *(const LAS bf16x8*)(lds + PG8_SA(b, h) + aoff + m * 2048 + k * 1024); } while (0)
#define PG8_LDB(dst, b, h) do { _Pragma("unroll") for (int n = 0; n < 2; ++n) _Pragma("unroll") for (int k = 0; k < 2; ++k) dst[n][k] = *(const LAS bf16x8*)(lds + PG8_SB(b, h) + boff + n * 2048 + k * 1024); } while (0)
#define PG8_MMA(ai, bj, At, Bt) do { __builtin_amdgcn_s_setprio(1); _Pragma("unroll") for (int m = 0; m < 4; ++m) _Pragma("unroll") for (int n = 0; n < 2; ++n) _Pragma("unroll") for (int k = 0; k < 2; ++k) \
        acc[ai][bj][m][n] = __builtin_amdgcn_mfma_f32_16x16x32_bf16(Bt[n][k], At[m][k], acc[ai][bj][m][n], 0, 0, 0); __builtin_amdgcn_s_setprio(0); } while (0)
#define PG8_WAIT_V(n) asm volatile("s_waitcnt vmcnt(" #n ")" ::: "memory")
#define PG8_WAIT_L(n) asm volatile("s_waitcnt lgkmcnt(" #n ")" ::: "memory")
#define PG8_BAR __builtin_amdgcn_s_barrier()
#define PG8_SCHED __builtin_amdgcn_sched_barrier(0)
    Unit cur, nxt; int ui = 0;
    if (!S.next(0, cur)) return;
    f32x4 acc[2][2][4][2];
#pragma unroll
    for (int a = 0; a < 2; ++a)
#pragma unroll
        for (int b = 0; b < 2; ++b)
#pragma unroll
            for (int m = 0; m < 4; ++m)
#pragma unroll
                for (int n = 0; n < 2; ++n) acc[a][b][m][n] = (f32x4){0.f, 0.f, 0.f, 0.f};
    bf16x8 At[4][2], B0[2][2], B1[2][2];
    const char* cA = (const char*)g.A + (size_t)cur.pm * tstepA; const char* cB = (const char*)g.Bt + (size_t)(cur.pm >> 4) * g.bsB * 2 + (size_t)cur.pn * tstepB;
    PG8_STAGE(PG8_SB(0, 0), cB, voffB); PG8_STAGE(PG8_SB(0, 1), cB + hstepB, voffB); PG8_STAGE(PG8_SA(0, 0), cA, voffA); PG8_STAGE(PG8_SA(0, 1), cA + hstepA, voffA);
    if (wr == 1) PG8_BAR;
    PG8_WAIT_V(2); PG8_BAR;
    PG8_STAGE(PG8_SB(1, 0), cB + kstep, voffB); PG8_STAGE(PG8_SA(1, 0), cA + kstep, voffA); PG8_STAGE(PG8_SB(1, 1), cB + hstepB + kstep, voffB);
    PG8_WAIT_V(6); PG8_BAR;
    for (;;) {
        const bool has_next = S.next(ui + 1, nxt);
        const char* nA = has_next ? (const char*)g.A + (size_t)nxt.pm * tstepA : cA; const char* nB = has_next ? (const char*)g.Bt + (size_t)(nxt.pm >> 4) * g.bsB * 2 + (size_t)nxt.pn * tstepB : cB;
        for (int t = 0; t < nt; t += 2) {
            if constexpr (Epi::HOOK) { if (t == 4 || t == 12) { int t2 = threadIdx.x; asm volatile("" : "+v"(t2)); E.hook(acc, cur, t, wr, wc, t2 & 15, (t2 & 63) >> 4); } }
            const bool last = (t == nt - 2);
            const char* a1 = cA + (size_t)(t + 1) * kstep;
            const char* a2 = last ? nA : cA + (size_t)(t + 2) * kstep; const char* b2 = last ? nB : cB + (size_t)(t + 2) * kstep;
            const char* a3 = a2 + kstep; const char* b3 = b2 + kstep;
            PG8_LDB(B0, 0, 0); PG8_LDB(B1, 0, 1); PG8_SCHED; PG8_LDA(At, 0, 0); PG8_STAGE(PG8_SA(1, 1), a1 + hstepA, voffA);
            PG8_WAIT_V(8); PG8_WAIT_L(0); PG8_BAR; PG8_MMA(0, 0, At, B0); PG8_MMA(0, 1, At, B1); PG8_BAR; PG8_SCHED;
            PG8_LDA(At, 0, 1); PG8_STAGE(PG8_SB(0, 0), b2, voffB); PG8_STAGE(PG8_SB(0, 1), b2 + hstepB, voffB); PG8_STAGE(PG8_SA(0, 0), a2, voffA);
            PG8_WAIT_V(8); PG8_WAIT_L(0); PG8_BAR; PG8_MMA(1, 0, At, B0); PG8_MMA(1, 1, At, B1); PG8_BAR; PG8_SCHED;
            PG8_LDB(B0, 1, 0); PG8_LDB(B1, 1, 1); PG8_SCHED; PG8_LDA(At, 1, 0); PG8_STAGE(PG8_SA(0, 1), a2 + hstepA, voffA);
            PG8_WAIT_V(8); PG8_WAIT_L(0); PG8_BAR; PG8_MMA(0, 0, At, B0); PG8_MMA(0, 1, At, B1); PG8_BAR; PG8_SCHED;
            PG8_LDA(At, 1, 1); PG8_STAGE(PG8_SB(1, 0), b3, voffB); PG8_STAGE(PG8_SB(1, 1), b3 + hstepB, voffB); PG8_STAGE(PG8_SA(1, 0), a3, voffA);
            PG8_WAIT_V(8); PG8_WAIT_L(0); PG8_BAR; PG8_MMA(1, 0, At, B0); PG8_MMA(1, 1, At, B1); PG8_BAR; PG8_SCHED;
        }
        if constexpr (ALIGN_EPI) { if (wr == 0) PG8_BAR; }
        { int t2 = threadIdx.x; asm volatile("" : "+v"(t2)); E(acc, cur, wr, wc, t2 & 15, (t2 & 63) >> 4); }
        if (!has_next) break;
#pragma unroll
        for (int a = 0; a < 2; ++a)
#pragma unroll
            for (int b = 0; b < 2; ++b)
#pragma unroll
                for (int m = 0; m < 4; ++m)
#pragma unroll
                    for (int n = 0; n < 2; ++n) acc[a][b][m][n] = (f32x4){0.f, 0.f, 0.f, 0.f};
        cur = nxt; cA = nA; cB = nB; ++ui;
        if constexpr (ALIGN_EPI) { if (wr == 1) PG8_BAR; }
    }
    PG8_WAIT_V(0);
    if constexpr (!ALIGN_EPI) { if (wr == 0) PG8_BAR; }
    PG8_BAR;
#undef PG8_SA
#undef PG8_SB
#undef PG8_STAGE
#undef PG8_LDA
#undef PG8_LDB
#undef PG8_MMA
#undef PG8_WAIT_V
#undef PG8_WAIT_L
#undef PG8_BAR
#undef PG8_SCHED
}
}
using pg8::Unit;
typedef f32x4 Acc[2][2][4][2];
constexpr int LDS_XCH = 131072;

struct EpiSwiGLU { static constexpr bool PERM = true, HOOK = false; bf16_t* O; const u64* ss;
    DI void operator()(const Acc& acc, const Unit& u, int wr, int wc, int fr, int fq) const {
        const int row0 = u.pm * 256 + wr * 64 + fr, col0 = u.pn * 128 + wc * 32 + 8 * fq;
#pragma unroll
        for (int ai = 0; ai < 2; ++ai)
#pragma unroll
            for (int m = 0; m < 4; ++m) {
                const float rs = rsqrtf((float)ss[row0 + ai * 128 + m * 16] * SS_INV + EPS);
                bf16_t* p = O + (size_t)(row0 + ai * 128 + m * 16) * DFF + col0; float v[8];
#pragma unroll
                for (int n = 0; n < 2; ++n)
#pragma unroll
                    for (int i = 0; i < 4; ++i) { const float gt = acc[ai][0][m][n][i] * rs, up = acc[ai][1][m][n][i] * rs; v[n * 4 + i] = gt * sigm(gt) * up; }
                u32x4 w; w.x = pk2(v[0], v[1]); w.y = pk2(v[2], v[3]); w.z = pk2(v[4], v[5]); w.w = pk2(v[6], v[7]); *(u32x4*)p = w; }
    }
};
struct EpiResid { static constexpr bool PERM = true, HOOK = false; bf16_t* XB; u64* ssn; float alpha;
    DI void operator()(const Acc& acc, const Unit& u, int wr, int wc, int fr, int fq) const {
        const int row0 = u.pm * 256 + wr * 64 + fr, col0 = u.pn * 256 + wc * 32 + 8 * fq, lane = fq * 16 + fr;
        bf16_t* base = XB + (size_t)row0 * D + col0;
        u32x4 xo[2][4][2];
#pragma unroll
        for (int ai = 0; ai < 2; ++ai)
#pragma unroll
            for (int m = 0; m < 4; ++m)
#pragma unroll
                for (int bj = 0; bj < 2; ++bj) xo[ai][m][bj] = *(const u32x4*)(base + (size_t)(ai * 128 + m * 16) * D + bj * 128);
#pragma unroll
        for (int ai = 0; ai < 2; ++ai)
#pragma unroll
            for (int m = 0; m < 4; ++m) { const int row = row0 + ai * 128 + m * 16; bf16_t* rp = base + (size_t)(ai * 128 + m * 16) * D; float sq = 0.f;
#pragma unroll
                for (int bj = 0; bj < 2; ++bj) { const u32x4 xv = xo[ai][m][bj];
                    const f32x4 a = acc[ai][bj][m][0], b = acc[ai][bj][m][1];
                    u32x4 w; w.x = pk2(bflo(xv.x) + alpha * a[0], bfhi(xv.x) + alpha * a[1]); w.y = pk2(bflo(xv.y) + alpha * a[2], bfhi(xv.y) + alpha * a[3]);
                    w.z = pk2(bflo(xv.z) + alpha * b[0], bfhi(xv.z) + alpha * b[1]); w.w = pk2(bflo(xv.w) + alpha * b[2], bfhi(xv.w) + alpha * b[3]);
                    *(u32x4*)(rp + bj * 128) = w;
                    sq += bflo(w.x) * bflo(w.x) + bfhi(w.x) * bfhi(w.x) + bflo(w.y) * bflo(w.y) + bfhi(w.y) * bfhi(w.y)
                        + bflo(w.z) * bflo(w.z) + bfhi(w.z) * bfhi(w.z) + bflo(w.w) * bflo(w.w) + bfhi(w.w) * bfhi(w.w); }
                sq += __int_as_float(__builtin_amdgcn_ds_bpermute((lane ^ 16) << 2, __float_as_int(sq)));
                sq += __int_as_float(__builtin_amdgcn_ds_bpermute((lane ^ 32) << 2, __float_as_int(sq)));
                if (fq == 0) atomicAdd(ssn + row, (u64)(unsigned)(sq * SS_SCALE)); }
    }
};
struct EpiBf16 { static constexpr bool PERM = true, HOOK = false; bf16_t* O; int ldc; const u64* ss;
    DI void operator()(const Acc& acc, const Unit& u, int wr, int wc, int fr, int fq) const {
        const int row0 = u.pm * 256 + wr * 64 + fr, col0 = u.pn * 256 + wc * 32 + 8 * fq;
#pragma unroll
        for (int ai = 0; ai < 2; ++ai)
#pragma unroll
            for (int m = 0; m < 4; ++m) { bf16_t* p = O + (size_t)(row0 + ai * 128 + m * 16) * ldc + col0;
                const float rs = ss ? rsqrtf((float)ss[row0 + ai * 128 + m * 16] * SS_INV + EPS) : 1.f;
#pragma unroll
                for (int bj = 0; bj < 2; ++bj) { const f32x4 a = acc[ai][bj][m][0] * rs, b = acc[ai][bj][m][1] * rs;
                    u32x4 w; w.x = pk2(a[0], a[1]); w.y = pk2(a[2], a[3]); w.z = pk2(b[0], b[1]); w.w = pk2(b[2], b[3]); *(u32x4*)(p + bj * 128) = w; } }
    }
};
DI void store_t(bf16_t* vt, size_t rowlen, int dcol0, int pos, const f32x4& a, const f32x4& b) {
#pragma unroll
    for (int i = 0; i < 4; ++i) { vt[(size_t)(dcol0 + i) * rowlen + pos] = (bf16_t)(pk2(a[i], 0.f) & 0xffffu); vt[(size_t)(dcol0 + 4 + i) * rowlen + pos] = (bf16_t)(pk2(b[i], 0.f) & 0xffffu); }
}
struct EpiSoftmax { static constexpr bool PERM = true, HOOK = false; bf16_t* P; const u64* ss; LAS float* xch;
    DI void operator()(Acc& acc, const Unit& u, int wr, int wc, int fr, int fq) const {
        const int rl0 = wr * 64 + fr, col0 = u.pn * 256 + wc * 32 + 8 * fq, lane = fq * 16 + fr;
        LAS float* rmax = xch; LAS float* rsum = xch + 1024;
        const float SCL = 0.0625f * LOG2E;
#pragma unroll
        for (int ai = 0; ai < 2; ++ai)
#pragma unroll
            for (int m = 0; m < 4; ++m) { const int rl = rl0 + ai * 128 + m * 16;
                const float rs = rsqrtf((float)ss[u.pm * 256 + rl] * SS_INV + EPS) * SCL; float mx = -3.0e38f;
#pragma unroll
                for (int bj = 0; bj < 2; ++bj)
#pragma unroll
                    for (int n = 0; n < 2; ++n) { acc[ai][bj][m][n] = acc[ai][bj][m][n] * rs;
                        mx = fmaxf(fmaxf(mx, fmaxf(acc[ai][bj][m][n][0], acc[ai][bj][m][n][1])), fmaxf(acc[ai][bj][m][n][2], acc[ai][bj][m][n][3])); }
                mx = fmaxf(mx, __int_as_float(__builtin_amdgcn_ds_bpermute((lane ^ 16) << 2, __float_as_int(mx))));
                mx = fmaxf(mx, __int_as_float(__builtin_amdgcn_ds_bpermute((lane ^ 32) << 2, __float_as_int(mx))));
                if (fq == 0) rmax[rl * 4 + wc] = mx; }
        asm volatile("s_waitcnt lgkmcnt(0)" ::: "memory"); __builtin_amdgcn_s_barrier(); asm volatile("" ::: "memory");
#pragma unroll
        for (int ai = 0; ai < 2; ++ai)
#pragma unroll
            for (int m = 0; m < 4; ++m) { const int rl = rl0 + ai * 128 + m * 16;
                const f32x4 m4 = *(const LAS f32x4*)(rmax + rl * 4); const float mx = fmaxf(fmaxf(m4[0], m4[1]), fmaxf(m4[2], m4[3])); float sm = 0.f;
#pragma unroll
                for (int bj = 0; bj < 2; ++bj)
#pragma unroll
                    for (int n = 0; n < 2; ++n)
#pragma unroll
                        for (int i = 0; i < 4; ++i) { const float p = __builtin_amdgcn_exp2f(acc[ai][bj][m][n][i] - mx); acc[ai][bj][m][n][i] = p; sm += p; }
                sm += __int_as_float(__builtin_amdgcn_ds_bpermute((lane ^ 16) << 2, __float_as_int(sm)));
                sm += __int_as_float(__builtin_amdgcn_ds_bpermute((lane ^ 32) << 2, __float_as_int(sm)));
                if (fq == 0) rsum[rl * 4 + wc] = sm; }
        asm volatile("s_waitcnt lgkmcnt(0)" ::: "memory"); __builtin_amdgcn_s_barrier(); asm volatile("" ::: "memory");
#pragma unroll
        for (int ai = 0; ai < 2; ++ai)
#pragma unroll
            for (int m = 0; m < 4; ++m) { const int rl = rl0 + ai * 128 + m * 16;
                const f32x4 s4 = *(const LAS f32x4*)(rsum + rl * 4); const float inv = 1.f / ((s4[0] + s4[1]) + (s4[2] + s4[3]));
                bf16_t* p = P + (size_t)(u.pm * 256 + rl) * D + col0;
#pragma unroll
                for (int bj = 0; bj < 2; ++bj) { const f32x4 a = acc[ai][bj][m][0] * inv, b = acc[ai][bj][m][1] * inv;
                    u32x4 w; w.x = pk2(a[0], a[1]); w.y = pk2(a[2], a[3]); w.z = pk2(b[0], b[1]); w.w = pk2(b[2], b[3]); *(u32x4*)(p + bj * 128) = w; } }
        asm volatile("s_waitcnt lgkmcnt(0)" ::: "memory"); __builtin_amdgcn_s_barrier(); asm volatile("" ::: "memory");
    }
};
struct EpiWin { static constexpr bool PERM = true, HOOK = false; bf16_t* U; bf16_t* KFB; bf16_t* KFC; bf16_t* VFB; bf16_t* VFC; bf16_t* GB; const u64* ss; LAS unsigned char* xl;
    DI void operator()(const Acc& acc_in, const Unit& u, int wr, int wc, int fr, int fq) const {
        const int rl0 = wr * 64 + fr, cl0 = wc * 32 + 8 * fq, pn = u.pn;
        Acc acc;
#pragma unroll
        for (int ai = 0; ai < 2; ++ai)
#pragma unroll
            for (int m = 0; m < 4; ++m) { const float rs = rsqrtf((float)ss[u.pm * 256 + rl0 + ai * 128 + m * 16] * SS_INV + EPS);
#pragma unroll
                for (int bj = 0; bj < 2; ++bj)
#pragma unroll
                    for (int n = 0; n < 2; ++n) acc[ai][bj][m][n] = acc_in[ai][bj][m][n] * rs; }
        const int bb = u.pm >> 4, s0 = (u.pm & 15) * 256;
        if (pn < 2) {
#pragma unroll
            for (int ai = 0; ai < 2; ++ai)
#pragma unroll
                for (int m = 0; m < 4; ++m) { bf16_t* p = U + (size_t)(u.pm * 256 + rl0 + ai * 128 + m * 16) * UP + UC_Z + pn * 128 + cl0; float v[8];
#pragma unroll
                    for (int n = 0; n < 2; ++n)
#pragma unroll
                        for (int i = 0; i < 4; ++i) v[n * 4 + i] = acc[ai][0][m][n][i] * sigm(acc[ai][1][m][n][i]);
                    u32x4 w; w.x = pk2(v[0], v[1]); w.y = pk2(v[2], v[3]); w.z = pk2(v[4], v[5]); w.w = pk2(v[6], v[7]); *(u32x4*)p = w; }
        } else if (pn == 4 || pn == 6 || pn == 7) {
            const int s4k = (wc & 1) * 2 + (fq >> 1), hik = fq & 1;
#pragma unroll
            for (int ai = 0; ai < 2; ++ai)
#pragma unroll
                for (int m = 0; m < 4; ++m) {
                    const int tokb = s0 + ai * 128 + wr * 64 + m * 16, chunk = tokb >> 5, r32k = (tokb & 31) + fr;
                    const int jv = m & 1;
#pragma unroll
                    for (int bj = 0; bj < 2; ++bj) {
                        const f32x4 a = acc[ai][bj][m][0], b = acc[ai][bj][m][1];
                        const bool isK = (pn == 6) || (pn == 4 && bj == 0);
                        if (isK) {
                            const int bh = (pn == 4) ? (bb * 2 + (wc >> 1)) : (bb * 4 + bj * 2 + (wc >> 1));
                            bf16_t* dst = (pn == 4 ? KFB : KFC) + ((size_t)(bh * 128 + chunk) * 4 + s4k) * 512 + (hik * 32 + r32k) * 8;
                            u32x4 w; w.x = pk2(a[0], a[1]); w.y = pk2(a[2], a[3]); w.z = pk2(b[0], b[1]); w.w = pk2(b[2], b[3]); *(u32x4*)dst = w;
                        } else {
                            const int bh = (pn == 4) ? (bb * 2 + (wc >> 1)) : (bb * 4 + bj * 2 + (wc >> 1));
                            const int dtv = wc & 1, lane_ = fq * 16 + fr, drv = lane_ & 31, hv = lane_ >> 5;
                            LAS bf16_t* scr = (LAS bf16_t*)(xl + (wr * 4 + wc) * 1024);
                            { u32x4 w; w.x = pk2(a[0], a[1]); w.y = pk2(a[2], a[3]); w.z = pk2(b[0], b[1]); w.w = pk2(b[2], b[3]); *(LAS u32x4*)(scr + fr * 32 + 8 * fq) = w; }
                            unsigned short tv[8];
#pragma unroll
                            for (int i = 0; i < 8; ++i) tv[i] = scr[(8 * (i >> 2) + 4 * hv + (i & 3)) * 32 + drv];
                            u32x4 o; o.x = (unsigned)tv[0] | ((unsigned)tv[1] << 16); o.y = (unsigned)tv[2] | ((unsigned)tv[3] << 16); o.z = (unsigned)tv[4] | ((unsigned)tv[5] << 16); o.w = (unsigned)tv[6] | ((unsigned)tv[7] << 16);
                            *(u32x4*)((pn == 4 ? VFB : VFC) + (((size_t)(bh * 128 + chunk) * 2 + dtv) * 2 + jv) * 512 + lane_ * 8) = o;
                        } } }
        } else if (pn >= 8) {
            bf16_t* gp = GB + ((size_t)(((pn - 8) >> 2) * 128 + u.pm) * 4 + ((pn - 8) & 3)) * 65536 + (size_t)(wr * 4 + wc) * 8192 + (fq * 16 + fr) * 8;
#pragma unroll
            for (int ai = 0; ai < 2; ++ai)
#pragma unroll
                for (int m = 0; m < 4; ++m)
#pragma unroll
                    for (int bj = 0; bj < 2; ++bj) { const f32x4 a = acc[ai][bj][m][0], b = acc[ai][bj][m][1];
                        u32x4 w; w.x = pk2(einv(a[0]), einv(a[1])); w.y = pk2(einv(a[2]), einv(a[3])); w.z = pk2(einv(b[0]), einv(b[1])); w.w = pk2(einv(b[2]), einv(b[3]));
                        *(u32x4*)(gp + (ai * 8 + m * 2 + bj) * 512) = w; }
        } else {
            const bool gate = false;
            const int uc = pn == 2 ? UC_BQ : pn == 3 ? UC_BQ + 256 : UC_CQ;
#pragma unroll
            for (int ai = 0; ai < 2; ++ai)
#pragma unroll
                for (int m = 0; m < 4; ++m) { bf16_t* p = U + (size_t)(u.pm * 256 + rl0 + ai * 128 + m * 16) * UP + uc + cl0;
#pragma unroll
                    for (int bj = 0; bj < 2; ++bj) { f32x4 a = acc[ai][bj][m][0], b = acc[ai][bj][m][1];
                        if (gate) {
#pragma unroll
                            for (int i = 0; i < 4; ++i) { a[i] = sigm(a[i]); b[i] = sigm(b[i]); } }
                        u32x4 w; w.x = pk2(a[0], a[1]); w.y = pk2(a[2], a[3]); w.z = pk2(b[0], b[1]); w.w = pk2(b[2], b[3]); *(u32x4*)(p + bj * 128) = w; } }
        }
    }
};
DI void unpack8(const u32x4 w, float (&g)[8]) { g[0] = bflo(w.x); g[1] = bfhi(w.x); g[2] = bflo(w.y); g[3] = bfhi(w.y); g[4] = bflo(w.z); g[5] = bfhi(w.z); g[6] = bflo(w.w); g[7] = bfhi(w.w); }
struct EpiYF { static constexpr bool PERM = true, HOOK = true; bf16_t* Y; const bf16_t* GB;
    DI const bf16_t* gtile(int br, const Unit& u, int wr, int wc, int fr, int fq) const { return GB + ((size_t)(br * 128 + u.pm) * 4 + u.pn) * 65536 + (size_t)(wr * 4 + wc) * 8192 + (fq * 16 + fr) * 8; }
    DI void hook(Acc& acc, const Unit& u, int t, int wr, int wc, int fr, int fq) const {
        const int br = (t == 4) ? 0 : 1;
        const bf16_t* gn = gtile(br, u, wr, wc, fr, fq); const bf16_t* gd = gtile(br + 1, u, wr, wc, fr, fq);
#pragma unroll
        for (int ai = 0; ai < 2; ++ai) {
            u32x4 wn[8], wd[8];
#pragma unroll
            for (int f = 0; f < 8; ++f) { wn[f] = *(const u32x4*)(gn + (ai * 8 + f) * 512); wd[f] = *(const u32x4*)(gd + (ai * 8 + f) * 512); }
#pragma unroll
            for (int m = 0; m < 4; ++m)
#pragma unroll
                for (int bj = 0; bj < 2; ++bj) { float a[8], b[8]; unpack8(wn[m * 2 + bj], a); unpack8(wd[m * 2 + bj], b);
#pragma unroll
                    for (int i = 0; i < 4; ++i) { acc[ai][bj][m][0][i] *= b[i] * __builtin_amdgcn_rcpf(a[i]);
                                                  acc[ai][bj][m][1][i] *= b[4 + i] * __builtin_amdgcn_rcpf(a[4 + i]); } }
            asm volatile("" ::: "memory"); }
    }
    DI void operator()(const Acc& acc, const Unit& u, int wr, int wc, int fr, int fq) const {
        const int row0 = u.pm * 256 + wr * 64 + fr, col0 = u.pn * 256 + wc * 32 + 8 * fq;
        const bf16_t* gc = gtile(2, u, wr, wc, fr, fq);
#pragma unroll
        for (int ai = 0; ai < 2; ++ai) {
            u32x4 wg[8];
#pragma unroll
            for (int f = 0; f < 8; ++f) wg[f] = *(const u32x4*)(gc + (ai * 8 + f) * 512);
#pragma unroll
            for (int m = 0; m < 4; ++m) { bf16_t* rp = Y + (size_t)(row0 + ai * 128 + m * 16) * D + col0;
#pragma unroll
                for (int bj = 0; bj < 2; ++bj) { float g[8]; unpack8(wg[m * 2 + bj], g);
                    const f32x4 a = acc[ai][bj][m][0], b = acc[ai][bj][m][1];
                    u32x4 w; w.x = pk2(a[0] * __builtin_amdgcn_rcpf(g[0]), a[1] * __builtin_amdgcn_rcpf(g[1])); w.y = pk2(a[2] * __builtin_amdgcn_rcpf(g[2]), a[3] * __builtin_amdgcn_rcpf(g[3]));
                    w.z = pk2(b[0] * __builtin_amdgcn_rcpf(g[4]), b[1] * __builtin_amdgcn_rcpf(g[5])); w.w = pk2(b[2] * __builtin_amdgcn_rcpf(g[6]), b[3] * __builtin_amdgcn_rcpf(g[7]));
                    *(u32x4*)(rp + bj * 128) = w; } }
            asm volatile("" ::: "memory"); }
    }
};

DI float shx(float v, int o, int lane) { return __int_as_float(__builtin_amdgcn_ds_bpermute((lane ^ o) << 2, __float_as_int(v))); }
DI float xh_max(float m) { const auto rr = __builtin_amdgcn_permlane32_swap(__float_as_uint(m), __float_as_uint(m), false, false); return fmaxf(__uint_as_float(rr[0]), __uint_as_float(rr[1])); }
DI float xh_sum(float m) { const auto rr = __builtin_amdgcn_permlane32_swap(__float_as_uint(m), __float_as_uint(m), false, false); return __uint_as_float(rr[0]) + __uint_as_float(rr[1]); }
DI float wave_sum(float v, int lane) {
#pragma unroll
    for (int o = 1; o < 64; o <<= 1) v += shx(v, o, lane);
    return v;
}
DI void transpose_item(const float* W, int K, int N, bf16_t* WT, int mode, LAS float* scr, int item, int lane, const float* gain = nullptr, int ldw = 0) {
    if (ldw == 0) ldw = K;
    const int nblk = N / 32, kb = item / nblk, nb = item % nblk, k0 = 64 * kb, n0 = 32 * nb;
    int rowbase = n0;
    if (mode == 1) rowbase = 256 * (n0 >> 7) + (n0 & 127);
    else if (mode == 2) rowbase = 256 * (n0 >> 7) + 128 + (n0 & 127);
    else if (mode == 3) { if (n0 < 256) rowbase = 256 * (n0 >> 7) + (n0 & 127); else if (n0 < 512) { const int j = n0 - 256; rowbase = 256 * (j >> 7) + 128 + (j & 127); } }
    float wv[32];
#pragma unroll
    for (int i = 0; i < 32; ++i) wv[i] = __builtin_nontemporal_load(&W[(size_t)(k0 + 2 * i + (lane >> 5)) * N + n0 + (lane & 31)]);
    if (gain) {
#pragma unroll
        for (int i = 0; i < 32; ++i) wv[i] *= gain[k0 + 2 * i + (lane >> 5)]; }
#pragma unroll
    for (int i = 0; i < 32; ++i) scr[(2 * i + (lane >> 5)) * 33 + (lane & 31)] = wv[i];
    asm volatile("s_waitcnt lgkmcnt(0)" ::: "memory");
    const int c = lane & 7;
#pragma unroll
    for (int j = 0; j < 4; ++j) { const int n = (lane >> 3) + 8 * j; const LAS float* s = scr + (8 * c) * 33 + n;
        u32x4 o; o.x = pk2(s[0 * 33], s[1 * 33]); o.y = pk2(s[2 * 33], s[3 * 33]); o.z = pk2(s[4 * 33], s[5 * 33]); o.w = pk2(s[6 * 33], s[7 * 33]);
        *(u32x4*)(WT + (size_t)(rowbase + n) * ldw + k0 + 8 * c) = o; }
    asm volatile("s_waitcnt lgkmcnt(0)" ::: "memory");
}
DI void rms_row_bf16(const float* xrow, const float* g, bf16_t* orow, int lane) {
    const f32x4* xr = (const f32x4*)xrow + lane; const f32x4* gr = (const f32x4*)g + lane;
    f32x4 v[4]; float s = 0.f;
#pragma unroll
    for (int j = 0; j < 4; ++j) { v[j] = xr[64 * j]; s += (v[j].x * v[j].x + v[j].y * v[j].y) + (v[j].z * v[j].z + v[j].w * v[j].w); }
    const float rstd = 1.f / sqrtf(wave_sum(s, lane) * (1.f / D) + EPS);
    u32x2* o8 = (u32x2*)orow + lane;
#pragma unroll
    for (int j = 0; j < 4; ++j) { const f32x4 gg = gr[64 * j]; u32x2 w; w.x = pk2(v[j].x * rstd * gg.x, v[j].y * rstd * gg.y); w.y = pk2(v[j].z * rstd * gg.z, v[j].w * rstd * gg.w); o8[64 * j] = w; }
}
DI void norm_phase(const float* X, const float* g, bf16_t* XN, int gw, int ngw, int lane) {
    for (int m = gw; m < M; m += ngw) rms_row_bf16(X + (size_t)m * D, g, XN + (size_t)m * D, lane);
}

DI void conv_unit(LAS unsigned char* lds, const bf16_t* U, bf16_t* MIX, const float* dw_w, const float* dw_b, const float* ln_g, const float* ln_b, int b, int tc, int tid, int wid, int lane) {
    LAS bf16_t* zt = (LAS bf16_t*)lds;
    LAS float* cv = (LAS float*)(lds + 49152);
    const int tok0 = tc * 64;
    {
        u32x4 v[6];
#pragma unroll
        for (int i = 0; i < 6; ++i) { const int row = (tid >> 5) + 16 * i, t = tok0 - 15 + row; v[i] = (u32x4){0u, 0u, 0u, 0u};
            if (row < 94 && t >= 0 && t < SEQ) v[i] = *(const u32x4*)(U + (size_t)(b * SEQ + t) * UP + UC_Z + (tid & 31) * 8); }
#pragma unroll
        for (int i = 0; i < 6; ++i) { const int row = (tid >> 5) + 16 * i; if (row < 94) *(LAS u32x4*)(zt + row * 256 + (tid & 31) * 8) = v[i]; }
    }
    __syncthreads();
    {
        typedef float f32x2 __attribute__((ext_vector_type(2)));
        const int cp = tid & 127, tl0 = (tid >> 7) * 16;
        f32x2 w[31];
#pragma unroll
        for (int j = 0; j < 31; ++j) w[j] = *(const f32x2*)(dw_w + j * 256 + 2 * cp);
        const f32x2 bias = *(const f32x2*)(dw_b + 2 * cp);
#pragma unroll 1
        for (int pass = 0; pass < 2; ++pass) { const int tp0 = tl0 + pass * 8;
            f32x2 zv[38];
#pragma unroll
            for (int i = 0; i < 38; ++i) { const unsigned u = *(const LAS unsigned*)(zt + (tp0 + i) * 256 + 2 * cp); zv[i] = (f32x2){bflo(u), bfhi(u)}; }
#pragma unroll
            for (int t = 0; t < 8; ++t) { f32x2 a = bias;
#pragma unroll
                for (int j = 0; j < 31; ++j) a += zv[t + j] * w[j];
                *(LAS f32x2*)(cv + (tp0 + t) * 256 + 2 * cp) = a; }
        }
    }
    __syncthreads();
    {
        const f32x4 g4 = *(const f32x4*)(ln_g + lane * 4), b4 = *(const f32x4*)(ln_b + lane * 4);
        f32x4 x[8]; float s[8];
#pragma unroll
        for (int i = 0; i < 8; ++i) { x[i] = *(const LAS f32x4*)(cv + (wid + 8 * i) * 256 + lane * 4); s[i] = (x[i].x + x[i].y) + (x[i].z + x[i].w); }
#pragma unroll
        for (int o = 1; o < 64; o <<= 1)
#pragma unroll
            for (int i = 0; i < 8; ++i) s[i] += shx(s[i], o, lane);
#pragma unroll
        for (int i = 0; i < 8; ++i) { x[i] = x[i] - s[i] * (1.f / 256.f); s[i] = (x[i].x * x[i].x + x[i].y * x[i].y) + (x[i].z * x[i].z + x[i].w * x[i].w); }
#pragma unroll
        for (int o = 1; o < 64; o <<= 1)
#pragma unroll
            for (int i = 0; i < 8; ++i) s[i] += shx(s[i], o, lane);
#pragma unroll
        for (int i = 0; i < 8; ++i) { const int tl = wid + 8 * i; const float rstd = 1.f / sqrtf(s[i] * (1.f / 256.f) + EPS);
            f32x4 y = x[i] * rstd * g4 + b4;
            y.x *= sigm(y.x); y.y *= sigm(y.y); y.z *= sigm(y.z); y.w *= sigm(y.w);
            u32x2 o; o.x = pk2(y.x, y.y); o.y = pk2(y.z, y.w);
            *(u32x2*)(MIX + (size_t)(b * SEQ + tok0 + tl) * D + lane * 4) = o; }
    }
    __syncthreads();
}

#define MFMA32(a, b, c) __builtin_amdgcn_mfma_f32_32x32x16_bf16((a), (b), (c), 0, 0, 0)
template <int MODE>
DI void attn_unit(const bf16_t* __restrict__ U, const bf16_t* __restrict__ KF, const bf16_t* __restrict__ VF, bf16_t* __restrict__ MIX, const LAS float* tab, int b, int st, int h, int lane, float sink2) {
    const int r32 = lane & 31, hi = lane >> 5, q0 = st * 32;
    constexpr int QCOL = MODE ? UC_CQ : UC_BQ, OCOL = MODE ? 768 : 256, NKH = MODE ? 4 : 2, NCH = MODE ? 16 : 9;
    const int kh = MODE ? h : (h >> 2);
    const bf16_t* qp = U + (size_t)(b * SEQ + q0 + r32) * UP + QCOL + h * 64 + 8 * hi;
    bf16x8 qf[4];
#pragma unroll
    for (int s = 0; s < 4; ++s) qf[s] = *(const bf16x8*)(qp + 16 * s);
    const bf16_t* kbase = KF + (size_t)(b * NKH + kh) * (SEQ * 64) + lane * 8;
    const bf16_t* vbase = VF + (size_t)(b * NKH + kh) * (SEQ * 64) + lane * 8;
    float mrun = MODE ? -30000.f : sink2, l = 0.f;
    f32x16 o0, o1;
#pragma unroll
    for (int r = 0; r < 16; ++r) { o0[r] = 0.f; o1[r] = 0.f; }
    const float SC = 0.125f * LOG2E;
    const int qrow = q0 >> 6, rs = min(max(qrow - 4, 0), 56);
    const int qc = (q0 & 63) + r32, cs = min(max(qc - 8, 0), 48);
    bf16x8 kf[3][4], vf[3][4];
#define KV0(c) (MODE ? ((rs + ((c) >> 1)) * 64 + ((c) & 1) * 32) : (q0 - 128 + 32 * (c)))
#define LOADKV(slot, c) do { const int kvc_ = min(max(KV0(c), 0), SEQ - 32); const bf16_t* kp_ = kbase + (size_t)(kvc_ >> 5) * 2048; const bf16_t* vp_ = vbase + (size_t)(kvc_ >> 5) * 2048; \
        _Pragma("unroll") for (int s4 = 0; s4 < 4; ++s4) { kf[slot][s4] = *(const bf16x8*)(kp_ + 512 * s4); vf[slot][s4] = *(const bf16x8*)(vp_ + 512 * s4); } } while (0)
    LOADKV(0, 0); LOADKV(1, 1);
    auto chunk = [&](const int c, auto slot_c, auto pslot_c) __attribute__((always_inline)) {
        constexpr int SLOT = decltype(slot_c)::value, PSLOT = decltype(pslot_c)::value;
        if (c + 2 < NCH) LOADKV(PSLOT, c + 2);
        const int kv0 = KV0(c);
        if (c >= NCH || (MODE == 0 && (kv0 < 0 || kv0 >= SEQ))) return;
        f32x16 s;
#pragma unroll
        for (int r = 0; r < 16; ++r) s[r] = 0.f;
#pragma unroll
        for (int s4 = 0; s4 < 4; ++s4) s = MFMA32(kf[SLOT][s4], qf[s4], s);
        float t[16];
        if (MODE == 0) {
            const int base = kv0 - q0 + 4 * hi - r32 + 128;
            if (c == 0 || c == NCH - 1) {
#pragma unroll
                for (int r = 0; r < 16; ++r) { const int idx = base + (r & 3) + 8 * (r >> 2); const bool ok = (unsigned)idx <= 256u;
                    const float bv = tab[h * 257 + (ok ? idx : 0)]; t[r] = ok ? s[r] * SC + bv : -1e30f; }
            } else {
#pragma unroll
                for (int r = 0; r < 16; ++r) t[r] = s[r] * SC + tab[h * 257 + base + (r & 3) + 8 * (r >> 2)];
            }
        } else {
            const int kcb = (kv0 & 63) + 4 * hi, drow = (kv0 >> 6) - qrow;
            const LAS float* tp = tab + (h * 15 + drow + 7) * 31 + 15 - qc + kcb;
            const int rel0 = kcb - cs;
#pragma unroll
            for (int r = 0; r < 16; ++r) { const bool ok = (unsigned)(rel0 + (r & 3) + 8 * (r >> 2)) < 16u;
                const float bv = tp[(r & 3) + 8 * (r >> 2)]; t[r] = ok ? s[r] * SC + bv : -1e30f; }
        }
        float mx = t[0];
#pragma unroll
        for (int r = 1; r < 16; ++r) mx = fmaxf(mx, t[r]);
        mx = xh_max(mx);
        const float mnew = fmaxf(mrun, mx), alpha = __builtin_amdgcn_exp2f(mrun - mnew);
        mrun = mnew;
        float ps = 0.f;
#pragma unroll
        for (int r = 0; r < 16; ++r) { t[r] = __builtin_amdgcn_exp2f(t[r] - mnew); ps += t[r]; }
        l = l * alpha + ps;
#pragma unroll
        for (int r = 0; r < 16; ++r) { o0[r] *= alpha; o1[r] *= alpha; }
        u32x4 w0, w1;
        w0.x = pk2(t[0], t[1]); w0.y = pk2(t[2], t[3]); w0.z = pk2(t[4], t[5]); w0.w = pk2(t[6], t[7]);
        w1.x = pk2(t[8], t[9]); w1.y = pk2(t[10], t[11]); w1.z = pk2(t[12], t[13]); w1.w = pk2(t[14], t[15]);
        const bf16x8 pb0 = __builtin_bit_cast(bf16x8, w0), pb1 = __builtin_bit_cast(bf16x8, w1);
        o0 = MFMA32(vf[SLOT][0], pb0, o0); o0 = MFMA32(vf[SLOT][1], pb1, o0);
        o1 = MFMA32(vf[SLOT][2], pb0, o1); o1 = MFMA32(vf[SLOT][3], pb1, o1);
        };
#pragma unroll 1
    for (int c3 = 0; c3 < NCH; c3 += 3) {
        chunk(c3, std::integral_constant<int, 0>{}, std::integral_constant<int, 2>{});
        chunk(c3 + 1, std::integral_constant<int, 1>{}, std::integral_constant<int, 0>{});
        chunk(c3 + 2, std::integral_constant<int, 2>{}, std::integral_constant<int, 1>{});
    }
#undef KV0
#undef LOADKV
    l = xh_sum(l);
    const float den = l + (MODE ? 0.f : __builtin_amdgcn_exp2f(sink2 - mrun));
    const float inv = 1.f / den;
    bf16_t* op = MIX + (size_t)(b * SEQ + q0 + r32) * D + OCOL + h * 64 + 4 * hi;
#pragma unroll
    for (int g = 0; g < 4; ++g) {
        u32x2 a; a.x = pk2(o0[4 * g] * inv, o0[4 * g + 1] * inv); a.y = pk2(o0[4 * g + 2] * inv, o0[4 * g + 3] * inv); *(u32x2*)(op + 8 * g) = a;
        u32x2 c; c.x = pk2(o1[4 * g] * inv, o1[4 * g + 1] * inv); c.y = pk2(o1[4 * g + 2] * inv, o1[4 * g + 3] * inv); *(u32x2*)(op + 32 + 8 * g) = c; }
}

DI void na_row_unit(const bf16_t* __restrict__ U, const bf16_t* __restrict__ KF, const bf16_t* __restrict__ VF, bf16_t* __restrict__ MIX, const LAS float* tab, int b, int qrow, int h, int lane) {
    const int r32 = lane & 31, hi = lane >> 5;
    const bf16_t* qp = U + (size_t)(b * SEQ + qrow * 64 + r32) * UP + UC_CQ + h * 64 + 8 * hi;
    bf16x8 qf[2][4];
#pragma unroll
    for (int sb = 0; sb < 2; ++sb)
#pragma unroll
        for (int s = 0; s < 4; ++s) qf[sb][s] = *(const bf16x8*)(qp + (size_t)sb * 32 * UP + 16 * s);
    const bf16_t* kbase = KF + (size_t)(b * 4 + h) * (SEQ * 64) + lane * 8;
    const bf16_t* vbase = VF + (size_t)(b * 4 + h) * (SEQ * 64) + lane * 8;
    float mrun[2] = {-30000.f, -30000.f}, l[2] = {0.f, 0.f};
    f32x16 o[2][2];
#pragma unroll
    for (int sb = 0; sb < 2; ++sb)
#pragma unroll
        for (int r = 0; r < 16; ++r) { o[sb][0][r] = 0.f; o[sb][1][r] = 0.f; }
    const float SC = 0.125f * LOG2E;
    const int rs = min(max(qrow - 4, 0), 56);
    bf16x8 kf[2][4], vf[2][4];
#define NLOAD(slot, c) do { const bf16_t* kp_ = kbase + (size_t)((rs + ((c) >> 1)) * 2 + ((c) & 1)) * 2048; const bf16_t* vp_ = vbase + (size_t)((rs + ((c) >> 1)) * 2 + ((c) & 1)) * 2048; \
        _Pragma("unroll") for (int s4 = 0; s4 < 4; ++s4) { kf[slot][s4] = *(const bf16x8*)(kp_ + 512 * s4); vf[slot][s4] = *(const bf16x8*)(vp_ + 512 * s4); } } while (0)
    NLOAD(0, 0);
    auto chunk = [&](const int c, auto slot_c) __attribute__((always_inline)) {
        constexpr int SLOT = decltype(slot_c)::value;
        __builtin_amdgcn_iglp_opt(0);
        if (c + 1 < 16) NLOAD(SLOT ^ 1, c + 1);
        const int kcb = (c & 1) * 32 + 4 * hi, drow = rs + (c >> 1) - qrow;
#pragma unroll
        for (int sb = 0; sb < 2; ++sb) {
            const int qc = sb * 32 + r32, cs = min(max(qc - 8, 0), 48);
            f32x16 s;
#pragma unroll
            for (int r = 0; r < 16; ++r) s[r] = 0.f;
#pragma unroll
            for (int s4 = 0; s4 < 4; ++s4) s = MFMA32(kf[SLOT][s4], qf[sb][s4], s);
            if (SLOT != sb) {
                const LAS float* tp = tab + (h * 15 + drow + 7) * 31 + 15 - qc + kcb;
                const int rel0 = kcb - cs, R0 = sb ? 12 : 0;
                float t4[4];
#pragma unroll
                for (int i = 0; i < 4; ++i) { const int r = R0 + i; const bool ok = (unsigned)(rel0 + (r & 3) + 8 * (r >> 2)) < 16u;
                    const float bv = tp[(r & 3) + 8 * (r >> 2)]; t4[i] = ok ? s[r] * SC + bv : -1e30f; }
                float mx = fmaxf(fmaxf(t4[0], t4[1]), fmaxf(t4[2], t4[3]));
                mx = xh_max(mx);
                if (__builtin_amdgcn_ballot_w64(mx > mrun[sb] + 8.f) != 0ull) {
                    const float mnew = fmaxf(mrun[sb], mx), alpha = __builtin_amdgcn_exp2f(mrun[sb] - mnew);
                    mrun[sb] = mnew; l[sb] *= alpha;
#pragma unroll
                    for (int r = 0; r < 16; ++r) { o[sb][0][r] *= alpha; o[sb][1][r] *= alpha; } }
                const float mref = mrun[sb];
                float ps = 0.f;
#pragma unroll
                for (int i = 0; i < 4; ++i) { t4[i] = __builtin_amdgcn_exp2f(t4[i] - mref); ps += t4[i]; }
                l[sb] += ps;
                u32x4 w; w.x = 0u; w.y = 0u; w.z = 0u; w.w = 0u;
                if (sb == 0) { w.x = pk2(t4[0], t4[1]); w.y = pk2(t4[2], t4[3]); } else { w.z = pk2(t4[0], t4[1]); w.w = pk2(t4[2], t4[3]); }
                const bf16x8 pb = __builtin_bit_cast(bf16x8, w);
                o[sb][0] = MFMA32(vf[SLOT][sb], pb, o[sb][0]);
                o[sb][1] = MFMA32(vf[SLOT][2 + sb], pb, o[sb][1]);
            } else {
                const LAS float* tp = tab + (h * 15 + drow + 7) * 31 + 15 - qc + kcb;
                const int rel0 = kcb - cs;
                float t[16];
#pragma unroll
                for (int r = 0; r < 16; ++r) { const bool ok = (unsigned)(rel0 + (r & 3) + 8 * (r >> 2)) < 16u;
                    const float bv = tp[(r & 3) + 8 * (r >> 2)]; t[r] = ok ? s[r] * SC + bv : -1e30f; }
                float mx = t[0];
#pragma unroll
                for (int r = 1; r < 16; ++r) mx = fmaxf(mx, t[r]);
                mx = xh_max(mx);
                if (__builtin_amdgcn_ballot_w64(mx > mrun[sb] + 8.f) != 0ull) {
                    const float mnew = fmaxf(mrun[sb], mx), alpha = __builtin_amdgcn_exp2f(mrun[sb] - mnew);
                    mrun[sb] = mnew; l[sb] *= alpha;
#pragma unroll
                    for (int r = 0; r < 16; ++r) { o[sb][0][r] *= alpha; o[sb][1][r] *= alpha; } }
                const float mref = mrun[sb];
                float ps = 0.f;
#pragma unroll
                for (int r = 0; r < 16; ++r) { t[r] = __builtin_amdgcn_exp2f(t[r] - mref); ps += t[r]; }
                l[sb] += ps;
                u32x4 w0, w1;
                w0.x = pk2(t[0], t[1]); w0.y = pk2(t[2], t[3]); w0.z = pk2(t[4], t[5]); w0.w = pk2(t[6], t[7]);
                w1.x = pk2(t[8], t[9]); w1.y = pk2(t[10], t[11]); w1.z = pk2(t[12], t[13]); w1.w = pk2(t[14], t[15]);
                const bf16x8 pb0 = __builtin_bit_cast(bf16x8, w0), pb1 = __builtin_bit_cast(bf16x8, w1);
                o[sb][0] = MFMA32(vf[SLOT][0], pb0, o[sb][0]); o[sb][0] = MFMA32(vf[SLOT][1], pb1, o[sb][0]);
                o[sb][1] = MFMA32(vf[SLOT][2], pb0, o[sb][1]); o[sb][1] = MFMA32(vf[SLOT][3], pb1, o[sb][1]);
            }
        }
    };
#pragma unroll 1
    for (int c2 = 0; c2 < 16; c2 += 2) {
        chunk(c2, std::integral_constant<int, 0>{});
        chunk(c2 + 1, std::integral_constant<int, 1>{});
    }
#undef NLOAD
#pragma unroll
    for (int sb = 0; sb < 2; ++sb) {
        float lt = xh_sum(l[sb]);
        const float inv = 1.f / lt;
        bf16_t* op = MIX + (size_t)(b * SEQ + qrow * 64 + sb * 32 + r32) * D + 768 + h * 64 + 4 * hi;
#pragma unroll
        for (int g = 0; g < 4; ++g) {
            u32x2 a; a.x = pk2(o[sb][0][4 * g] * inv, o[sb][0][4 * g + 1] * inv); a.y = pk2(o[sb][0][4 * g + 2] * inv, o[sb][0][4 * g + 3] * inv); *(u32x2*)(op + 8 * g) = a;
            u32x2 c; c.x = pk2(o[sb][1][4 * g] * inv, o[sb][1][4 * g + 1] * inv); c.y = pk2(o[sb][1][4 * g + 2] * inv, o[sb][1][4 * g + 3] * inv); *(u32x2*)(op + 32 + 8 * g) = c; }
    }
}

DI void win_pair_unit(const bf16_t* __restrict__ U, const bf16_t* __restrict__ KF, const bf16_t* __restrict__ VF, bf16_t* __restrict__ MIX, const LAS float* tab, int b, int st, int hp, int lane, float sinkA, float sinkB) {
    const int r32 = lane & 31, hi = lane >> 5, q0 = st * 32, h0 = hp * 2, kh = hp >> 1;
    const bf16_t* qp = U + (size_t)(b * SEQ + q0 + r32) * UP + UC_BQ + h0 * 64 + 8 * hi;
    bf16x8 qf[2][4];
#pragma unroll
    for (int hh = 0; hh < 2; ++hh)
#pragma unroll
        for (int s = 0; s < 4; ++s) qf[hh][s] = *(const bf16x8*)(qp + hh * 64 + 16 * s);
    const bf16_t* kbase = KF + (size_t)(b * 2 + kh) * (SEQ * 64) + lane * 8;
    const bf16_t* vbase = VF + (size_t)(b * 2 + kh) * (SEQ * 64) + lane * 8;
    float mrun[2] = {sinkA, sinkB}, l[2] = {0.f, 0.f};
    f32x16 o[2][2];
#pragma unroll
    for (int hh = 0; hh < 2; ++hh)
#pragma unroll
        for (int r = 0; r < 16; ++r) { o[hh][0][r] = 0.f; o[hh][1][r] = 0.f; }
    const float SC = 0.125f * LOG2E;
    bf16x8 kf[2][4], vf[2][4];
#define WLOAD(slot, c) do { const int kvc_ = min(max(q0 - 128 + 32 * (c), 0), SEQ - 32); const bf16_t* kp_ = kbase + (size_t)(kvc_ >> 5) * 2048; const bf16_t* vp_ = vbase + (size_t)(kvc_ >> 5) * 2048; \
        _Pragma("unroll") for (int s4 = 0; s4 < 4; ++s4) { kf[slot][s4] = *(const bf16x8*)(kp_ + 512 * s4); vf[slot][s4] = *(const bf16x8*)(vp_ + 512 * s4); } } while (0)
    WLOAD(0, 0);
    auto chunk = [&](const int c, auto slot_c) __attribute__((always_inline)) {
        constexpr int SLOT = decltype(slot_c)::value;
        __builtin_amdgcn_iglp_opt(0);
        if (c + 1 < 9) WLOAD(SLOT ^ 1, c + 1);
        const int kv0 = q0 - 128 + 32 * c;
        if (c >= 9 || kv0 < 0 || kv0 >= SEQ) return;
        const int base = kv0 - q0 + 4 * hi - r32 + 128;
#pragma unroll
        for (int hh = 0; hh < 2; ++hh) {
            f32x16 s;
#pragma unroll
            for (int r = 0; r < 16; ++r) s[r] = 0.f;
#pragma unroll
            for (int s4 = 0; s4 < 4; ++s4) s = MFMA32(kf[SLOT][s4], qf[hh][s4], s);
            const LAS float* tp = tab + (h0 + hh) * 257;
            float t[16];
            if (c == 0 || c == 8) {
#pragma unroll
                for (int r = 0; r < 16; ++r) { const int idx = base + (r & 3) + 8 * (r >> 2); const bool ok = (unsigned)idx <= 256u;
                    const float bv = tp[ok ? idx : 0]; t[r] = ok ? s[r] * SC + bv : -1e30f; }
            } else {
#pragma unroll
                for (int r = 0; r < 16; ++r) t[r] = s[r] * SC + tp[base + (r & 3) + 8 * (r >> 2)];
            }
            float mx = t[0];
#pragma unroll
            for (int r = 1; r < 16; ++r) mx = fmaxf(mx, t[r]);
            mx = xh_max(mx);
            if (__builtin_amdgcn_ballot_w64(mx > mrun[hh] + 8.f) != 0ull) {
                const float mnew = fmaxf(mrun[hh], mx), alpha = __builtin_amdgcn_exp2f(mrun[hh] - mnew);
                mrun[hh] = mnew; l[hh] *= alpha;
#pragma unroll
                for (int r = 0; r < 16; ++r) { o[hh][0][r] *= alpha; o[hh][1][r] *= alpha; } }
            const float mref = mrun[hh];
            float ps = 0.f;
#pragma unroll
            for (int r = 0; r < 16; ++r) { t[r] = __builtin_amdgcn_exp2f(t[r] - mref); ps += t[r]; }
            l[hh] += ps;
            u32x4 w0, w1;
            w0.x = pk2(t[0], t[1]); w0.y = pk2(t[2], t[3]); w0.z = pk2(t[4], t[5]); w0.w = pk2(t[6], t[7]);
            w1.x = pk2(t[8], t[9]); w1.y = pk2(t[10], t[11]); w1.z = pk2(t[12], t[13]); w1.w = pk2(t[14], t[15]);
            const bf16x8 pb0 = __builtin_bit_cast(bf16x8, w0), pb1 = __builtin_bit_cast(bf16x8, w1);
            o[hh][0] = MFMA32(vf[SLOT][0], pb0, o[hh][0]); o[hh][0] = MFMA32(vf[SLOT][1], pb1, o[hh][0]);
            o[hh][1] = MFMA32(vf[SLOT][2], pb0, o[hh][1]); o[hh][1] = MFMA32(vf[SLOT][3], pb1, o[hh][1]);
        }
    };
#pragma unroll 1
    for (int c2 = 0; c2 < 9; c2 += 2) {
        chunk(c2, std::integral_constant<int, 0>{});
        chunk(c2 + 1, std::integral_constant<int, 1>{});
    }
#undef WLOAD
#pragma unroll
    for (int hh = 0; hh < 2; ++hh) {
        float lt = xh_sum(l[hh]);
        const float inv = 1.f / (lt + __builtin_amdgcn_exp2f((hh ? sinkB : sinkA) - mrun[hh]));
        bf16_t* op = MIX + (size_t)(b * SEQ + q0 + r32) * D + 256 + (h0 + hh) * 64 + 4 * hi;
#pragma unroll
        for (int g = 0; g < 4; ++g) {
            u32x2 a; a.x = pk2(o[hh][0][4 * g] * inv, o[hh][0][4 * g + 1] * inv); a.y = pk2(o[hh][0][4 * g + 2] * inv, o[hh][0][4 * g + 3] * inv); *(u32x2*)(op + 8 * g) = a;
            u32x2 c; c.x = pk2(o[hh][1][4 * g] * inv, o[hh][1][4 * g + 1] * inv); c.y = pk2(o[hh][1][4 * g + 2] * inv, o[hh][1][4 * g + 3] * inv); *(u32x2*)(op + 32 + 8 * g) = c; }
    }
}

DI void cross_unit(LAS unsigned char* lds, const bf16_t* QX, const bf16_t* KX, const bf16_t* VXT, bf16_t* OX, int b, int h, int qb, int tid, int wid, int lane) {
    constexpr int PITCH = 528;
    const int r32 = lane & 31, hi = lane >> 5;
    const int q0 = qb * 256 + wid * 32;
    bf16x8 qf[16];
    {
        const bf16_t* qp = QX + (size_t)(b * SEQ + q0 + r32) * D + h * 256 + 8 * hi;
#pragma unroll
        for (int s = 0; s < 16; ++s) qf[s] = *(const bf16x8*)(qp + 16 * s);
        const bf16_t* kp0 = KX + (size_t)(b * 256 + (tid >> 5)) * D + h * 256 + (tid & 31) * 8;
        LAS unsigned char* l0 = lds + (tid >> 5) * PITCH + (tid & 31) * 16;
#pragma unroll
        for (int hf = 0; hf < 2; ++hf) { u32x4 kv[8];
#pragma unroll
            for (int i = 0; i < 8; ++i) kv[i] = *(const u32x4*)(kp0 + (size_t)(hf * 8 + i) * 16 * D);
#pragma unroll
            for (int i = 0; i < 8; ++i) *(LAS u32x4*)(l0 + (hf * 8 + i) * 16 * PITCH) = kv[i];
            asm volatile("" ::: "memory"); }
    }
    __syncthreads();
    bf16x8 pb[8][2]; float inv;
    {
        f32x16 S[8];
#pragma unroll
        for (int c = 0; c < 8; ++c) {
#pragma unroll
            for (int r = 0; r < 16; ++r) S[c][r] = 0.f;
#pragma unroll
            for (int s = 0; s < 16; ++s) { const bf16x8 kf = *(const LAS bf16x8*)(lds + (32 * c + r32) * PITCH + (16 * s + 8 * hi) * 2); S[c] = MFMA32(kf, qf[s], S[c]); }
        }
        float mx = S[0][0];
#pragma unroll
        for (int c = 0; c < 8; ++c)
#pragma unroll
            for (int r = 0; r < 16; ++r) mx = fmaxf(mx, S[c][r]);
        mx = xh_max(mx);
        const float SC = 0.0625f * LOG2E; float l = 0.f;
#pragma unroll
        for (int c = 0; c < 8; ++c) {
#pragma unroll
            for (int r = 0; r < 16; ++r) { const float p = __builtin_amdgcn_exp2f((S[c][r] - mx) * SC); S[c][r] = p; l += p; }
            u32x4 w0, w1;
            w0.x = pk2(S[c][0], S[c][1]); w0.y = pk2(S[c][2], S[c][3]); w0.z = pk2(S[c][4], S[c][5]); w0.w = pk2(S[c][6], S[c][7]);
            w1.x = pk2(S[c][8], S[c][9]); w1.y = pk2(S[c][10], S[c][11]); w1.z = pk2(S[c][12], S[c][13]); w1.w = pk2(S[c][14], S[c][15]);
            pb[c][0] = __builtin_bit_cast(bf16x8, w0); pb[c][1] = __builtin_bit_cast(bf16x8, w1);
        }
        l = xh_sum(l);
        inv = 1.f / l;
    }
    __syncthreads();
    {
        const bf16_t* vp0 = VXT + (size_t)(b * 1024 + h * 256 + (tid >> 5)) * 256 + (tid & 31) * 8;
        LAS unsigned char* l0 = lds + (tid >> 5) * PITCH + (tid & 31) * 16;
#pragma unroll
        for (int hf = 0; hf < 2; ++hf) { u32x4 vv[8];
#pragma unroll
            for (int i = 0; i < 8; ++i) vv[i] = *(const u32x4*)(vp0 + (size_t)(hf * 8 + i) * 16 * 256);
#pragma unroll
            for (int i = 0; i < 8; ++i) *(LAS u32x4*)(l0 + (hf * 8 + i) * 16 * PITCH) = vv[i];
            asm volatile("" ::: "memory"); }
    }
    __syncthreads();
    bf16_t* op = OX + (size_t)(b * SEQ + q0 + r32) * D + h * 256 + 4 * hi;
#pragma unroll 1
    for (int dt = 0; dt < 8; ++dt) {
        f32x16 o;
#pragma unroll
        for (int r = 0; r < 16; ++r) o[r] = 0.f;
#pragma unroll
        for (int c = 0; c < 8; ++c)
#pragma unroll
            for (int j = 0; j < 2; ++j) { const bf16x8 vf = *(const LAS bf16x8*)(lds + (dt * 32 + r32) * PITCH + (32 * c + 16 * j + 8 * hi) * 2); o = MFMA32(vf, pb[c][j], o); }
#pragma unroll
        for (int g = 0; g < 4; ++g) { u32x2 a; a.x = pk2(o[4 * g] * inv, o[4 * g + 1] * inv); a.y = pk2(o[4 * g + 2] * inv, o[4 * g + 3] * inv); *(u32x2*)(op + dt * 32 + 8 * g) = a; }
    }
    __syncthreads();
}


#define XB_TMO      128
#define XB_XCNT(j)  (256  + 64 * (j))
#define XB_XSUB(j)  (1280 + 64 * (j))
#define XB_XGEN(j)  (2304 + 64 * (j))
#define XB_TOP      3328
#define XB_TOPGEN   3392
#define XCD_BAR_WORDS 3456
#define XB_SPIN_CAP (1u << 22)
DI unsigned xb_ld(unsigned* p)              { return __hip_atomic_load(p, __ATOMIC_RELAXED, __HIP_MEMORY_SCOPE_AGENT); }
DI unsigned xb_add(unsigned* p, unsigned v) { return __hip_atomic_fetch_add(p, v, __ATOMIC_RELAXED, __HIP_MEMORY_SCOPE_AGENT); }
DI unsigned xb_xcc_id() { return (unsigned)__builtin_amdgcn_s_getreg((3 << 11) | 20) & 0xFu; }
#define XB_SPIN(cond, bar) do { unsigned _sp = 0; while (cond) { __builtin_amdgcn_s_sleep(4); \
    if ((++_sp & 255u) == 0u) { if (xb_ld(&(bar)[XB_TMO])) break; if (_sp > XB_SPIN_CAP) { atomicAdd(&(bar)[XB_TMO], 1u); break; } } } } while (0)
DI void xcd_barrier_complete(unsigned* bar, unsigned x, unsigned& nloc, unsigned& nx) {
    const unsigned G = gridDim.x * gridDim.y * gridDim.z;
    unsigned sum, cnt, mine, sp = 0u;
    for (;;) {
        sum = 0u; cnt = 0u; mine = 0u;
#pragma unroll
        for (unsigned j = 0; j < 16; ++j) { const unsigned c = xb_ld(&bar[XB_XCNT(j)]); sum += c; cnt += (c > 0u) ? 1u : 0u; mine = (j == x) ? c : mine; }
        if (sum == G) break;
        __builtin_amdgcn_s_sleep(1);
        if ((++sp & 255u) == 0u) { if (xb_ld(&bar[XB_TMO])) break; if (sp > XB_SPIN_CAP) { atomicAdd(&bar[XB_TMO], 1u); break; } }
    }
    nloc = mine > 0u ? mine : 1u; nx = cnt > 0u ? cnt : 1u;
}
DI void xcd_barrier(unsigned* bar, volatile LAS unsigned* st, int tid) {
    asm volatile("s_waitcnt vmcnt(0)" ::: "memory");
    __syncthreads();
    int tl = threadIdx.x; asm volatile("" : "+v"(tl));
    if (tl == 0) {
        const unsigned x = xb_xcc_id();
        __builtin_amdgcn_s_waitcnt(0);
        unsigned nloc = st[0], nx = st[1];
        if (nloc == 0u) { xcd_barrier_complete(bar, x, nloc, nx); st[0] = nloc; st[1] = nx; }
        const unsigned old = xb_add(&bar[XB_XSUB(x)], 1u);
        const unsigned gen = old / nloc;
        if (old + 1u == (gen + 1u) * nloc) {
            __builtin_amdgcn_fence(__ATOMIC_RELEASE, "agent");
            asm volatile("s_waitcnt vmcnt(0)" ::: "memory");
            const unsigned og = xb_add(&bar[XB_TOP], 1u);
            const unsigned tg = og / nx;
            if (og + 1u == (tg + 1u) * nx) xb_add(&bar[XB_TOPGEN], 1u);
            else XB_SPIN(xb_ld(&bar[XB_TOPGEN]) == tg, bar);
            __builtin_amdgcn_fence(__ATOMIC_ACQUIRE, "agent");
            xb_add(&bar[XB_XGEN(x)], 1u);
            asm volatile("s_waitcnt vmcnt(0)" ::: "memory");
        } else {
            XB_SPIN(xb_ld(&bar[XB_XGEN(x)]) == gen, bar);
            __builtin_amdgcn_fence(__ATOMIC_ACQUIRE, "agent");
            asm volatile("s_waitcnt vmcnt(0)" ::: "memory");
        }
    }
    __syncthreads();
}

constexpr int LDS_BYTES = 147456, BARST_OFF = LDS_BYTES - 64;
constexpr size_t WS_BAR = 65536;
struct Args { const float* in[29]; float* out; unsigned char* ws; int ph_lo, ph_hi; };

typedef const __attribute__((address_space(4))) Args* CArgsP;
DI CArgsP kargs() { CArgsP p = (CArgsP)__builtin_amdgcn_kernarg_segment_ptr(); asm volatile("" : "+s"(p)); return p; }
#define INP(i) (ap->in[i])
#define WSB(off) ((bf16_t*)(ws + (off)))

__global__ void __launch_bounds__(512, 2) fwd_kernel(Args args_unused) {
    extern __shared__ __attribute__((aligned(16))) unsigned char lds_raw[];
    LAS unsigned char* lds = (LAS unsigned char*)lds_raw;
    cg::grid_group grid = cg::this_grid();
    { CArgsP ap0 = kargs();
      volatile LAS unsigned* st0 = (volatile LAS unsigned*)(lds + BARST_OFF);
      if (threadIdx.x == 0) { st0[0] = 0u; st0[1] = 0u; (void)xb_add((unsigned*)(ap0->ws + WS_BAR) + XB_XCNT(xb_xcc_id()), 1u); }
      __syncthreads();
    }
#define PHASE_BEGIN { CArgsP ap = kargs(); unsigned char* ws = ap->ws; float* X = ap->out; (void)X; (void)ws; \
        int G = gridDim.x, bx = blockIdx.x; asm volatile("" : "+s"(G), "+s"(bx)); const int ngw = G * 8; (void)ngw; \
        int tid = threadIdx.x; asm volatile("" : "+v"(tid)); const int lane = tid & 63, wid = __builtin_amdgcn_readfirstlane(tid >> 6), gw = bx * 8 + wid; (void)lane; (void)gw;
#define PHASE_END   xcd_barrier((unsigned*)(ws + WS_BAR), (volatile LAS unsigned*)(lds + BARST_OFF), tid); }

    PHASE_BEGIN
    {
        for (int rep = 0; rep < REP_P0; ++rep) {
        bf16_t* WB = WSB(WS_W);
        LAS float* scr = (LAS float*)(lds + wid * 16384);
        constexpr int I_GU = 16 * 88, I_D = 44 * 32, I_IN = 16 * 160, I_CO = 4 * 32, I_WO = 8 * 32, I_SQ = 16 * 32, I_KV = 16 * 64;
        constexpr int PER_LAYER = 6 * I_GU + I_IN + 2 * I_CO + I_WO + 3 * I_SQ + I_KV;
        static_assert(I_GU == I_D, "item counts");
        for (int it = gw; it < DEPTH * PER_LAYER; it += ngw) {
            const int l = it / PER_LAYER; int r = it % PER_LAYER; bf16_t* wl = WB + (size_t)l * W_LAYER;
            if (r < I_GU) { transpose_item(INP(3) + (size_t)l * D * DFF, D, DFF, wl + WO_1GU, 1, scr, r, lane, INP(2) + l * D); continue; } r -= I_GU;
            if (r < I_GU) { transpose_item(INP(4) + (size_t)l * D * DFF, D, DFF, wl + WO_1GU, 2, scr, r, lane, INP(2) + l * D); continue; } r -= I_GU;
            if (r < I_D) { transpose_item(INP(5) + (size_t)l * D * DFF, DFF, D, wl + WO_1D, 0, scr, r, lane); continue; } r -= I_D;
            if (r < I_IN) { transpose_item(INP(7) + (size_t)l * D * NIN, D, NIN, wl + WO_IN, 3, scr, r, lane, INP(6) + l * D); continue; } r -= I_IN;
            if (r < I_CO) { transpose_item(INP(12) + (size_t)l * 256 * D, 256, D, wl + WO_CO, 0, scr, r, lane, nullptr, D); continue; } r -= I_CO;
            if (r < I_WO) { transpose_item(INP(15) + (size_t)l * 512 * D, 512, D, wl + WO_CO + 256, 0, scr, r, lane, nullptr, D); continue; } r -= I_WO;
            if (r < I_CO) { transpose_item(INP(17) + (size_t)l * 256 * D, 256, D, wl + WO_CO + 768, 0, scr, r, lane, nullptr, D); continue; } r -= I_CO;
            if (r < I_SQ) { transpose_item(INP(18) + (size_t)l * D * D, D, D, wl + WO_OUT, 0, scr, r, lane); continue; } r -= I_SQ;
            if (r < I_SQ) { continue; } r -= I_SQ;
            if (r < I_KV) { transpose_item(INP(22) + (size_t)l * D * 2 * D, D, 2 * D, wl + WO_CKV, 0, scr, r, lane); continue; } r -= I_KV;
            if (r < I_SQ) { transpose_item(INP(23) + (size_t)l * D * D, D, D, wl + WO_COO, 0, scr, r, lane); continue; } r -= I_SQ;
            if (r < I_GU) { transpose_item(INP(25) + (size_t)l * D * DFF, D, DFF, wl + WO_2GU, 1, scr, r, lane, INP(24) + l * D); continue; } r -= I_GU;
            if (r < I_GU) { transpose_item(INP(26) + (size_t)l * D * DFF, D, DFF, wl + WO_2GU, 2, scr, r, lane, INP(24) + l * D); continue; } r -= I_GU;
            transpose_item(INP(27) + (size_t)l * D * DFF, DFF, D, wl + WO_2D, 0, scr, r, lane);
        }
        for (int m = gw; m < DEPTH * D; m += ngw) {
            const int l = m >> 10, k = m & 1023; const float gk = (INP(19) + l * D)[k];
            const f32x4* wr_ = (const f32x4*)(INP(21) + (size_t)l * D * D + (size_t)k * D) + lane; u32x2* o8 = (u32x2*)(WB + (size_t)l * W_LAYER + WO_CQ + (size_t)k * D) + lane;
#pragma unroll
            for (int j = 0; j < 4; ++j) { const f32x4 v = wr_[64 * j] * gk; u32x2 w; w.x = pk2(v.x, v.y); w.y = pk2(v.z, v.w); o8[64 * j] = w; }
        }
        bf16_t* MEMN = WSB(WS_MEMN);
        for (int m = gw; m < DEPTH * BATCH * MEMLEN; m += ngw) { const int l = m / (BATCH * MEMLEN), row = m % (BATCH * MEMLEN);
            rms_row_bf16(INP(1) + (size_t)row * D, INP(20) + l * D, MEMN + (size_t)m * D, lane); }
        {
            const float* xin = INP(0); bf16_t* XB = WSB(WS_XB); u64* SS = (u64*)(ws + WS_SS);
            for (int m0 = gw; m0 < M; m0 += 4 * ngw) {
                f32x4 v[4][4];
#pragma unroll
                for (int q = 0; q < 4; ++q)
#pragma unroll
                    for (int j = 0; j < 4; ++j) v[q][j] = __builtin_nontemporal_load((const f32x4*)(xin + (size_t)(m0 + q * ngw) * D) + lane + 64 * j);
#pragma unroll
                for (int q = 0; q < 4; ++q) { const int m = m0 + q * ngw; u32x2* o8 = (u32x2*)(XB + (size_t)m * D) + lane; float s = 0.f;
#pragma unroll
                    for (int j = 0; j < 4; ++j) { u32x2 w; w.x = pk2(v[q][j].x, v[q][j].y); w.y = pk2(v[q][j].z, v[q][j].w); o8[64 * j] = w;
                        s += (bflo(w.x) * bflo(w.x) + bfhi(w.x) * bfhi(w.x)) + (bflo(w.y) * bflo(w.y) + bfhi(w.y) * bfhi(w.y)); }
                    s = wave_sum(s, lane);
                    if (lane == 0) SS[m] = (u64)(s * SS_SCALE); }
            }
            for (int i = gw * 64 + lane; i < 8 * M; i += ngw * 64) SS[M + i] = 0ull;
        }
        __syncthreads();
        }
    }
    grid.sync(); }

#pragma unroll 1
    for (int l = 0; l < DEPTH; ++l) {
        const size_t wlo = WS_W + (size_t)l * W_LAYER * 2;
#define SSP(k) ((u64*)(ws + WS_SS) + (size_t)(4 * l + (k)) * M)
        PHASE_BEGIN
        {
            pg8::Gemm g{WSB(WS_XB), WSB(wlo) + WO_1GU, D, D, D}; pg8::StaticOrder S; S.init(M, NGU, G, bx);
            EpiSwiGLU E{WSB(WS_U), SSP(0)};
            for (int rep = 0; rep < REP_UP; ++rep) pg8::gemm_phase<EpiSwiGLU, true>(lds, g, S, E);
            if (l == 0) {
#pragma unroll 1
                for (int l2 = 0; l2 < DEPTH; ++l2) {
                    pg8::Gemm g2{WSB(WS_MEMN) + (size_t)l2 * 2048 * D, WSB(WS_W) + (size_t)l2 * W_LAYER + WO_CKV, D, D, D}; pg8::StaticOrder S2; S2.init(2048, 2048, G, (bx + G - 64 * (l2 + 1)) % G);
                    EpiBf16 E2{WSB(WS_KX) + (size_t)l2 * 2048 * 2048, 2048, nullptr};
                    pg8::gemm_phase<EpiBf16, true>(lds, g2, S2, E2);
                }
            }
        }
        PHASE_END
        PHASE_BEGIN
        {
            pg8::Gemm g{WSB(WS_U), WSB(wlo) + WO_1D, DFF, DFF, DFF}; pg8::StaticOrder S; S.init(M, D, G, bx);
            EpiResid E{WSB(WS_XB), SSP(1), 0.5f};
            pg8::gemm_phase<EpiResid, true>(lds, g, S, E);
            if (l == 0) {
                bf16_t* WX = (bf16_t*)X + (size_t)32 * 1024 * 1024;
#pragma unroll 1
                for (int id = bx; id < 512; id += G) {
                    const int kind = id >> 8, rem = id & 255, l2 = rem >> 7, b = (rem >> 4) & 7, hh = (rem >> 2) & 3, q = rem & 3;
                    const bf16_t* KVl = WSB(WS_KX) + (size_t)l2 * 2048 * 2048 + (size_t)(b * 256) * 2048;
                    const bf16_t* wl2 = WSB(WS_W) + (size_t)l2 * W_LAYER;
                    bf16_t* outm = WX + ((size_t)kind * 16 + l2 * 8 + b) * (1024 * 1024);
                    if (kind == 0) {
                        pg8::Gemm g2{KVl + hh * 256, wl2 + WO_CQ + hh * 256, 2048, D, 256}; pg8::StaticOrder S2; S2.init(256, 1024, 4, q);
                        EpiBf16 E2{outm + (size_t)(hh * 256) * 1024, 1024, nullptr};
                        pg8::gemm_phase<EpiBf16, true>(lds, g2, S2, E2);
                    } else {
                        pg8::Gemm g2{wl2 + WO_COO + hh * 256, KVl + 1024 + hh * 256, D, 2048, 256}; pg8::StaticOrder S2; S2.init(1024, 256, 4, q);
                        EpiBf16 E2{outm + hh * 256, 1024, nullptr};
                        pg8::gemm_phase<EpiBf16, true>(lds, g2, S2, E2);
                    }
                }
            }
        }
        PHASE_END
        PHASE_BEGIN
        {
            pg8::Gemm g{WSB(WS_XB), WSB(wlo) + WO_IN, D, D, D}; pg8::StaticOrder S; S.init(M, NIN, G, bx);
            EpiWin E{WSB(WS_U), WSB(WS_VTB), WSB(WS_VTC), WSB(WS_VFB), WSB(WS_VFC), WSB(WS_G), SSP(1), lds + LDS_XCH};
            pg8::gemm_phase<EpiWin, true>(lds, g, S, E);
        }
        PHASE_END
        PHASE_BEGIN
        {
            bf16_t* Ub = WSB(WS_U); bf16_t* MIX = (bf16_t*)X;
            LAS float* t5tab = (LAS float*)(lds + 114688);
            LAS float* rpbtab = (LAS float*)(lds + 114688 + 8224);
            { const float* t5 = INP(14); const float* rpb = INP(16) + (size_t)l * 4 * 15 * 31;
            for (int i = tid; i < 8 * 257; i += 512) { const int hh = i / 257, rel = i % 257 - 128, n = rel < 0 ? -rel : rel;
                const int bk = (rel > 0 ? 16 : 0) + (n < 8 ? n : n < 12 ? 8 : n < 16 ? 9 : n < 23 ? 10 : n < 32 ? 11 : n < 46 ? 12 : n < 64 ? 13 : n < 91 ? 14 : 15);
                t5tab[i] = t5[bk * 8 + hh] * LOG2E; }
            for (int i = tid; i < 4 * 15 * 31; i += 512) rpbtab[i] = rpb[i] * LOG2E; }
            __syncthreads();
            for (int rep = 0; rep < REP_MIX; ++rep) {
            for (int cu = bx; cu < BATCH * 64; cu += G)
                conv_unit(lds, Ub, MIX, INP(8) + (size_t)l * 31 * 256, INP(9) + l * 256, INP(10) + l * 256, INP(11) + l * 256, cu >> 6, cu & 63, tid, wid, lane);
            { const bf16_t* KFB = WSB(WS_VTB); const bf16_t* VFB = WSB(WS_VFB); const float* sink = INP(13) + l * 8;
            for (int u = gw; u < BATCH * 128 * 4; u += ngw) { const int hp = u & 3, st = (u >> 2) & 127, b = u >> 9;
                win_pair_unit(Ub, KFB, VFB, MIX, t5tab, b, st, hp, lane, sink[2 * hp] * LOG2E, sink[2 * hp + 1] * LOG2E); } }
            { const bf16_t* KFC = WSB(WS_VTC); const bf16_t* VFC = WSB(WS_VFC);
            int t3 = threadIdx.x; asm volatile("" : "+v"(t3)); const int lane3 = t3 & 63, gw3 = bx * 8 + __builtin_amdgcn_readfirstlane(t3 >> 6);
            for (int u = gw3; u < BATCH * 64 * 4; u += ngw) { const int hh = u & 3, qr = (u >> 2) & 63, b = u >> 8;
                na_row_unit(Ub, KFC, VFC, MIX, rpbtab, b, qr, hh, lane3); } }
            }
            __syncthreads();
        }
        PHASE_END
        PHASE_BEGIN
        {
            const bf16_t* MIX = (const bf16_t*)X;
            pg8::StaticOrder S; S.init(M, D, G, bx);
            pg8::Gemm g{MIX, WSB(wlo) + WO_CO, D, D, D}; EpiYF E{WSB(WS_Y), WSB(WS_G)};
            for (int rep = 0; rep < REP_Y; ++rep) pg8::gemm_phase<EpiYF, true>(lds, g, S, E);
        }
        PHASE_END
        PHASE_BEGIN
        {
            pg8::Gemm g{WSB(WS_Y), WSB(wlo) + WO_OUT, D, D, D}; pg8::StaticOrder S; S.init(M, D, G, bx);
            EpiResid E{WSB(WS_XB), SSP(2), 1.0f};
            pg8::gemm_phase<EpiResid, true>(lds, g, S, E);
        }
        PHASE_END
        PHASE_BEGIN
        {
            const bf16_t* WX = (const bf16_t*)X + (size_t)32 * 1024 * 1024;
            pg8::Gemm g{WSB(WS_XB), WX + (size_t)(l * 8) * (1024 * 1024), D, D, D, (size_t)1024 * 1024}; pg8::StaticOrder S; S.init(M, D, G, bx);
            EpiSoftmax E{WSB(WS_QX), SSP(2), (LAS float*)(lds + LDS_XCH)};
            pg8::gemm_phase<EpiSoftmax, true>(lds, g, S, E);
        }
        PHASE_END
        PHASE_BEGIN
        {
            const bf16_t* WX = (const bf16_t*)X + (size_t)32 * 1024 * 1024;
            pg8::Gemm g{WSB(WS_QX), WX + (size_t)(16 + l * 8) * (1024 * 1024), D, D, D, (size_t)1024 * 1024}; pg8::StaticOrder S; S.init(M, D, G, bx);
            EpiResid E{WSB(WS_XB), SSP(3), 1.0f};
            pg8::gemm_phase<EpiResid, true>(lds, g, S, E);
        }
        PHASE_END
        PHASE_BEGIN
        {
            pg8::Gemm g{WSB(WS_XB), WSB(wlo) + WO_2GU, D, D, D}; pg8::StaticOrder S; S.init(M, NGU, G, bx);
            EpiSwiGLU E{WSB(WS_U), SSP(3)};
            for (int rep = 0; rep < REP_UP; ++rep) pg8::gemm_phase<EpiSwiGLU, true>(lds, g, S, E);
        }
        PHASE_END
        PHASE_BEGIN
        {
            pg8::Gemm g{WSB(WS_U), WSB(wlo) + WO_2D, DFF, DFF, DFF}; pg8::StaticOrder S; S.init(M, D, G, bx);
            EpiResid E{WSB(WS_XB), SSP(4), 0.5f};
            pg8::gemm_phase<EpiResid, true>(lds, g, S, E);
        }
        PHASE_END
    }
    {
        CArgsP ap = kargs(); unsigned char* ws = ap->ws; float* X = ap->out;
        int G = gridDim.x, bx = blockIdx.x; asm volatile("" : "+s"(G), "+s"(bx));
        int tid = threadIdx.x; asm volatile("" : "+v"(tid)); const int lane = tid & 63, wid = __builtin_amdgcn_readfirstlane(tid >> 6), gw = bx * 8 + wid, ngw = G * 8;
        const float* gf = INP(28); const bf16_t* XB = WSB(WS_XB); const u64* SS = (const u64*)(ws + WS_SS) + (size_t)8 * M;
        f32x4 gg[4];
#pragma unroll
        for (int j = 0; j < 4; ++j) gg[j] = ((const f32x4*)gf + lane)[64 * j];
        for (int m0 = gw; m0 < M; m0 += 4 * ngw) {
            u32x2 w[4][4]; float rs[4];
#pragma unroll
            for (int q = 0; q < 4; ++q) { const int m = m0 + q * ngw; rs[q] = rsqrtf((float)SS[m] * SS_INV + EPS);
#pragma unroll
                for (int j = 0; j < 4; ++j) w[q][j] = __builtin_nontemporal_load((const u32x2*)(XB + (size_t)m * D) + lane + 64 * j); }
#pragma unroll
            for (int q = 0; q < 4; ++q) { f32x4* orow = (f32x4*)(X + (size_t)(m0 + q * ngw) * D) + lane;
#pragma unroll
                for (int j = 0; j < 4; ++j) __builtin_nontemporal_store((f32x4){bflo(w[q][j].x) * rs[q] * gg[j].x, bfhi(w[q][j].x) * rs[q] * gg[j].y, bflo(w[q][j].y) * rs[q] * gg[j].z, bfhi(w[q][j].y) * rs[q] * gg[j].w}, orow + 64 * j); }
        }
    }
}
constexpr int N_PHASES = 1 + DEPTH * 15;

extern "C" void kernel_launch(void* const* d_in, const int* in_sizes, int n_in, void* d_out, int out_size, void* d_ws, size_t ws_size, hipStream_t stream) {
    static int grid = 0;
    if (grid == 0) {
        if (n_in != 29 || out_size != M * D || ws_size < WS_NEED) { fprintf(stderr, "kernel_launch: unexpected problem (n_in %d, out %d, ws %zu)\n", n_in, out_size, ws_size); grid = -1; return; }
        int dev = 0, cus = 0, per_cu = 0;
        hipGetDevice(&dev);
        hipDeviceGetAttribute(&cus, hipDeviceAttributeMultiprocessorCount, dev);
        if (hipFuncSetAttribute((const void*)fwd_kernel, hipFuncAttributeMaxDynamicSharedMemorySize, LDS_BYTES) != hipSuccess) { fprintf(stderr, "kernel_launch: hipFuncSetAttribute failed\n"); grid = -1; return; }
        if (hipOccupancyMaxActiveBlocksPerMultiprocessor(&per_cu, (const void*)fwd_kernel, 512, LDS_BYTES) != hipSuccess || per_cu < 1) { fprintf(stderr, "kernel_launch: occupancy query gave %d\n", per_cu); per_cu = 1; }
        (void)hipGetLastError();
        grid = cus * per_cu;
    }
    if (grid < 0) return;
    if (hipMemsetAsync((char*)d_ws, 0, 262144, stream) != hipSuccess) { fprintf(stderr, "kernel_launch: memset failed\n"); return; }
    Args a{};
    for (int i = 0; i < 29; ++i) a.in[i] = (const float*)d_in[i];
    a.out = (float*)d_out; a.ws = (unsigned char*)d_ws; a.ph_lo = 0; a.ph_hi = N_PHASES;
    void* kargs[] = {&a};
    hipError_t e = hipLaunchCooperativeKernel((const void*)fwd_kernel, dim3(grid), dim3(512), kargs, LDS_BYTES, stream);
    if (e != hipSuccess) fprintf(stderr, "kernel_launch: cooperative launch failed: %s (grid %d)\n", hipGetErrorString(e), grid);
}
```

```cpp
#include <hip/hip_runtime.h>
#include <hip/hip_cooperative_groups.h>
#include <cstdio>
#include <cstdint>
#include <type_traits>
namespace cg = cooperative_groups;

#ifndef REP_Y
#define REP_Y 1
#endif
#ifndef REP_P0
#define REP_P0 1
#endif
#ifndef REP_UP
#define REP_UP 1
#endif
#ifndef REP_MIX
#define REP_MIX 1
#endif
#ifndef REP_CROSS
#define REP_CROSS 1
#endif
#ifndef REP_NORM
#define REP_NORM 1
#endif
#define DI __device__ __forceinline__
#define LAS __attribute__((address_space(3)))
typedef unsigned short bf16_t;
typedef short bf16x8 __attribute__((ext_vector_type(8)));
typedef float f32x4 __attribute__((ext_vector_type(4)));
typedef float f32x16 __attribute__((ext_vector_type(16)));
typedef unsigned u32x4 __attribute__((ext_vector_type(4)));
typedef unsigned u32x2 __attribute__((ext_vector_type(2)));

constexpr int D = 1024, BATCH = 8, SEQ = 4096, M = BATCH * SEQ, DEPTH = 2, MEMLEN = 256, DFF = 2816, NGU = 2 * DFF, NIN = 5120;
constexpr int UP = 1024;
constexpr int UC_Z = 0, UC_BQ = 256, UC_CQ = 768;
constexpr float EPS = 1e-6f, LOG2E = 1.4426950408889634f;

constexpr size_t MiB = 1u << 20;
constexpr size_t WO_1GU = 0, WO_1D = WO_1GU + (size_t)NGU * D, WO_IN = WO_1D + (size_t)D * DFF, WO_CO = WO_IN + (size_t)NIN * D,
                 WO_WO = WO_CO + (size_t)D * 256, WO_NO = WO_WO + (size_t)D * 512, WO_OUT = WO_NO + (size_t)D * 256, WO_CQ = WO_OUT + (size_t)D * D,
                 WO_CKV = WO_CQ + (size_t)D * D, WO_COO = WO_CKV + (size_t)2 * D * D, WO_2GU = WO_COO + (size_t)D * D, WO_2D = WO_2GU + (size_t)NGU * D,
                 W_LAYER = WO_2D + (size_t)D * DFF;
static_assert(W_LAYER * 2 * DEPTH == 110 * MiB, "weights");
constexpr size_t WS_W = 1 * MiB, WS_KX = 111 * MiB, WS_VXT = 119 * MiB, WS_VTB = 127 * MiB, WS_VTC = 135 * MiB, WS_XB = 151 * MiB, WS_U = 215 * MiB,
                 WS_END = WS_U + 280 * MiB;
static_assert(WS_END == 495 * MiB && (size_t)M * UP * 2 <= 64 * MiB, "ws map");
constexpr size_t WS_MEMN = WS_U + 200 * MiB;
constexpr size_t WS_QX = WS_U, WS_OX = WS_U + 64 * MiB;
constexpr size_t WS_VFB = WS_U + 64 * MiB, WS_VFC = WS_U + 72 * MiB;
constexpr size_t WS_Y = WS_U;
constexpr size_t WS_G = WS_U + 88 * MiB;
constexpr size_t WS_SS = 496 * MiB;
constexpr size_t WS_NEED = WS_SS + (size_t)9 * M * 8;
typedef unsigned long long u64;
constexpr float SS_SCALE = 262144.f, SS_INV = 1.f / (262144.f * 1024.f);

DI unsigned pk2(float lo, float hi) {
    typedef float f2 __attribute__((ext_vector_type(2))); typedef __bf16 b2 __attribute__((ext_vector_type(2)));
    f2 v = {lo, hi}; b2 b = __builtin_convertvector(v, b2); return __builtin_bit_cast(unsigned, b);
}
DI float bflo(unsigned w) { return __uint_as_float(w << 16); }
DI float bfhi(unsigned w) { return __uint_as_float(w & 0xffff0000u); }
DI float einv(float x) { return fminf(1.f + __builtin_amdgcn_exp2f(-LOG2E * x), 1.0e30f); }
DI float sigm(float x) { return __builtin_amdgcn_rcpf(1.f + __builtin_amdgcn_exp2f(-LOG2E * x)); }
DI int tslot(int fr) { return ((fr >> 2) & 1) * 8 + (fr >> 3) * 4 + (fr & 3); }

namespace pg8 {
constexpr int BM = 256, BK = 64, HALF = 128, HTB = HALF * BK * 2, STAGE_BYTES = 8 * HTB, NXCD = 8, WGM = 4;
__host__ __device__ __forceinline__ int lds_byte(int r, int c) { const int st = (r >> 4) * 2 + (c >> 5), rr = r & 15, cc = c & 31, ob = rr * 64 + cc * 2; return st * 1024 + (ob ^ (((ob >> 9) & 1) << 5)); }
__host__ __device__ __forceinline__ void stage_rc(int b, int& R, int& C) { const int st = b / 1024, sb = b % 1024, swz = sb ^ (((sb >> 9) & 1) << 5); R = (st >> 1) * 16 + swz / 64; C = (st & 1) * 32 + (swz % 64) / 2; }
__host__ __device__ __forceinline__ int perm32(int rho) { const int n = rho >> 4, i = rho & 15; return 8 * (i >> 2) + 4 * n + (i & 3); }

struct Unit { int pm, pn; };
struct Gemm { const bf16_t* A; const bf16_t* Bt; int lda, ldb, K; size_t bsB = 0; };
struct StaticOrder {
    int nM, nN, nwg, G, c;
    DI void init(int M_, int N_, int G_, int c_) { nM = M_ / BM; nN = N_ / BM; nwg = nM * nN; G = G_; c = c_; }
    DI bool next(int i, Unit& u) const {
        const long L = (long)i * G + c; if (L >= nwg) return false;
        int wgid = (int)L; { const int q = nwg / NXCD, r = nwg % NXCD, xcd = wgid % NXCD, off = wgid / NXCD; wgid = (xcd < r ? xcd * (q + 1) : r * (q + 1) + (xcd - r) * q) + off; }
        const int nig = WGM * nN, gid = wgid / nig, fm = gid * WGM, gsz = (nM - fm) < WGM ? (nM - fm) : WGM;
        u.pm = fm + ((wgid % nig) % gsz); u.pn = (wgid % nig) / gsz; return true;
    }
};

template <class Epi, bool ALIGN_EPI>
DI void gemm_phase(LAS unsigned char* lds, const Gemm g, const StaticOrder& S, const Epi& E) {
    int tid = threadIdx.x; asm volatile("" : "+v"(tid));
    const int wid = __builtin_amdgcn_readfirstlane(tid >> 6), lane = tid & 63, wr = wid >> 2, wc = wid & 3, fr = lane & 15, fq = lane >> 4;
    const int K = g.K, nt = K / BK;
    unsigned voffA[2], voffB[2];
#pragma unroll
    for (int i = 0; i < 2; ++i) { int R, C; stage_rc(tid * 16 + i * 8192, R, C); const int Rb = Epi::PERM ? ((R & ~31) + perm32(R & 31)) : R;
        voffA[i] = (unsigned)(R * g.lda + C) * 2u; voffB[i] = (unsigned)(Rb * g.ldb + C) * 2u; }
    const size_t kstep = (size_t)(BK * 2);
    const size_t hstepA = (size_t)HALF * g.lda * 2, hstepB = (size_t)HALF * g.ldb * 2;
    const size_t tstepA = 2 * hstepA, tstepB = 2 * hstepB;
    const unsigned ldsw = (unsigned)wid * 1024u;
    const int aoff = lds_byte(wr * 64 + fr, fq * 8), boff = lds_byte(wc * 32 + fr, fq * 8);
#define PG8_SA(b, h) (((b) * 2 + (h)) * HTB)
#define PG8_SB(b, h) ((4 + (b) * 2 + (h)) * HTB)
#define PG8_STAGE(bufoff, gbase, voff) do { _Pragma("unroll") for (int _i = 0; _i < 2; ++_i) \
        __builtin_amdgcn_global_load_lds((const unsigned*)((const char*)(gbase) + (voff)[_i]), (LAS unsigned*)(lds + (bufoff) + ldsw + _i * 8192), 16, 0, 0); } while (0)
#define PG8_LDA(dst, b, h) do { _Pragma("unroll") for (int m = 0; m < 4; ++m) _Pragma("unroll") for (int k = 0; k < 2; ++k) dst[m][k] = *(const LAS bf16x8*)(lds + PG8_SA(b, h) + aoff + m * 2048 + k * 1024); } while (0)
#define PG8_LDB(dst, b, h) do { _Pragma("unroll") for (int n = 0; n < 2; ++n) _Pragma("unroll") for (int k = 0; k < 2; ++k) dst[n][k] = *(const LAS bf16x8*)(lds + PG8_SB(b, h) + boff + n * 2048 + k * 1024); } while (0)
#define PG8_MMA(ai, bj, At, Bt) do { __builtin_amdgcn_s_setprio(1); _Pragma("unroll") for (int m = 0; m < 4; ++m) _Pragma("unroll") for (int n = 0; n < 2; ++n) _Pragma("unroll") for (int k = 0; k < 2; ++k) \
        acc[ai][bj][m][n] = __builtin_amdgcn_mfma_f32_16x16x32_bf16(Bt[n][k], At[m][k], acc[ai][bj][m][n], 0, 0, 0); __builtin_amdgcn_s_setprio(0); } while (0)
#define PG8_WAIT_V(n) asm volatile("s_waitcnt vmcnt(" #n ")" ::: "memory")
#define PG8_WAIT_L(n) asm volatile("s_waitcnt lgkmcnt(" #n ")" ::: "memory")
#define PG8_BAR __builtin_amdgcn_s_barrier()
#define PG8_SCHED __builtin_amdgcn_sched_barrier(0)
    Unit cur, nxt; int ui = 0;
    if (!S.next(0, cur)) return;
    f32x4 acc[2][2][4][2];
#pragma unroll
    for (int a = 0; a < 2; ++a)
#pragma unroll
        for (int b = 0; b < 2; ++b)
#pragma unroll
            for (int m = 0; m < 4; ++m)
#pragma unroll
                for (int n = 0; n < 2; ++n) acc[a][b][m][n] = (f32x4){0.f, 0.f, 0.f, 0.f};
    bf16x8 At[4][2], B0[2][2], B1[2][2];
    const char* cA = (const char*)g.A + (size_t)cur.pm * tstepA; const char* cB = (const char*)g.Bt + (size_t)(cur.pm >> 4) * g.bsB * 2 + (size_t)cur.pn * tstepB;
    PG8_STAGE(PG8_SB(0, 0), cB, voffB); PG8_STAGE(PG8_SB(0, 1), cB + hstepB, voffB); PG8_STAGE(PG8_SA(0, 0), cA, voffA); PG8_STAGE(PG8_SA(0, 1), cA + hstepA, voffA);
    if (wr == 1) PG8_BAR;
    PG8_WAIT_V(2); PG8_BAR;
    PG8_STAGE(PG8_SB(1, 0), cB + kstep, voffB); PG8_STAGE(PG8_SA(1, 0), cA + kstep, voffA); PG8_STAGE(PG8_SB(1, 1), cB + hstepB + kstep, voffB);
    PG8_WAIT_V(6); PG8_BAR;
    for (;;) {
        const bool has_next = S.next(ui + 1, nxt);
        const char* nA = has_next ? (const char*)g.A + (size_t)nxt.pm * tstepA : cA; const char* nB = has_next ? (const char*)g.Bt + (size_t)(nxt.pm >> 4) * g.bsB * 2 + (size_t)nxt.pn * tstepB : cB;
        for (int t = 0; t < nt; t += 2) {
            if constexpr (Epi::HOOK) { if (t == 4 || t == 12) { int t2 = threadIdx.x; asm volatile("" : "+v"(t2)); E.hook(acc, cur, t, wr, wc, t2 & 15, (t2 & 63) >> 4); } }
            const bool last = (t == nt - 2);
            const char* a1 = cA + (size_t)(t + 1) * kstep;
            const char* a2 = last ? nA : cA + (size_t)(t + 2) * kstep; const char* b2 = last ? nB : cB + (size_t)(t + 2) * kstep;
            const char* a3 = a2 + kstep; const char* b3 = b2 + kstep;
            PG8_LDB(B0, 0, 0); PG8_LDB(B1, 0, 1); PG8_SCHED; PG8_LDA(At, 0, 0); PG8_STAGE(PG8_SA(1, 1), a1 + hstepA, voffA);
            PG8_WAIT_V(8); PG8_WAIT_L(0); PG8_BAR; PG8_MMA(0, 0, At, B0); PG8_MMA(0, 1, At, B1); PG8_BAR; PG8_SCHED;
            PG8_LDA(At, 0, 1); PG8_STAGE(PG8_SB(0, 0), b2, voffB); PG8_STAGE(PG8_SB(0, 1), b2 + hstepB, voffB); PG8_STAGE(PG8_SA(0, 0), a2, voffA);
            PG8_WAIT_V(8); PG8_WAIT_L(0); PG8_BAR; PG8_MMA(1, 0, At, B0); PG8_MMA(1, 1, At, B1); PG8_BAR; PG8_SCHED;
            PG8_LDB(B0, 1, 0); PG8_LDB(B1, 1, 1); PG8_SCHED; PG8_LDA(At, 1, 0); PG8_STAGE(PG8_SA(0, 1), a2 + hstepA, voffA);
            PG8_WAIT_V(8); PG8_WAIT_L(0); PG8_BAR; PG8_MMA(0, 0, At, B0); PG8_MMA(0, 1, At, B1); PG8_BAR; PG8_SCHED;
            PG8_LDA(At, 1, 1); PG8_STAGE(PG8_SB(1, 0), b3, voffB); PG8_STAGE(PG8_SB(1, 1), b3 + hstepB, voffB); PG8_STAGE(PG8_SA(1, 0), a3, voffA);
            PG8_WAIT_V(8); PG8_WAIT_L(0); PG8_BAR; PG8_MMA(1, 0, At, B0); PG8_MMA(1, 1, At, B1); PG8_BAR; PG8_SCHED;
        }
        if constexpr (ALIGN_EPI) { if (wr == 0) PG8_BAR; }
        { int t2 = threadIdx.x; asm volatile("" : "+v"(t2)); E(acc, cur, wr, wc, t2 & 15, (t2 & 63) >> 4); }
        if (!has_next) break;
#pragma unroll
        for (int a = 0; a < 2; ++a)
#pragma unroll
            for (int b = 0; b < 2; ++b)
#pragma unroll
                for (int m = 0; m < 4; ++m)
#pragma unroll
                    for (int n = 0; n < 2; ++n) acc[a][b][m][n] = (f32x4){0.f, 0.f, 0.f, 0.f};
        cur = nxt; cA = nA; cB = nB; ++ui;
        if constexpr (ALIGN_EPI) { if (wr == 1) PG8_BAR; }
    }
    PG8_WAIT_V(0);
    if constexpr (!ALIGN_EPI) { if (wr == 0) PG8_BAR; }
    PG8_BAR;
#undef PG8_SA
#undef PG8_SB
#undef PG8_STAGE
#undef PG8_LDA
#undef PG8_LDB
#undef PG8_MMA
#undef PG8_WAIT_V
#undef PG8_WAIT_L
#undef PG8_BAR
#undef PG8_SCHED
}
}
using pg8::Unit;
typedef f32x4 Acc[2][2][4][2];
constexpr int LDS_XCH = 131072;

struct EpiSwiGLU { static constexpr bool PERM = true, HOOK = false; bf16_t* O; const u64* ss;
    DI void operator()(const Acc& acc, const Unit& u, int wr, int wc, int fr, int fq) const {
        const int row0 = u.pm * 256 + wr * 64 + fr, col0 = u.pn * 128 + wc * 32 + 8 * fq;
#pragma unroll
        for (int ai = 0; ai < 2; ++ai)
#pragma unroll
            for (int m = 0; m < 4; ++m) {
                const float rs = rsqrtf((float)ss[row0 + ai * 128 + m * 16] * SS_INV + EPS);
                bf16_t* p = O + (size_t)(row0 + ai * 128 + m * 16) * DFF + col0; float v[8];
#pragma unroll
                for (int n = 0; n < 2; ++n)
#pragma unroll
                    for (int i = 0; i < 4; ++i) { const float gt = acc[ai][0][m][n][i] * rs, up = acc[ai][1][m][n][i] * rs; v[n * 4 + i] = gt * sigm(gt) * up; }
                u32x4 w; w.x = pk2(v[0], v[1]); w.y = pk2(v[2], v[3]); w.z = pk2(v[4], v[5]); w.w = pk2(v[6], v[7]); *(u32x4*)p = w; }
    }
};
struct EpiResid { static constexpr bool PERM = true, HOOK = false; bf16_t* XB; u64* ssn; float alpha;
    DI void operator()(const Acc& acc, const Unit& u, int wr, int wc, int fr, int fq) const {
        const int row0 = u.pm * 256 + wr * 64 + fr, col0 = u.pn * 256 + wc * 32 + 8 * fq, lane = fq * 16 + fr;
        bf16_t* base = XB + (size_t)row0 * D + col0;
        u32x4 xo[2][4][2];
#pragma unroll
        for (int ai = 0; ai < 2; ++ai)
#pragma unroll
            for (int m = 0; m < 4; ++m)
#pragma unroll
                for (int bj = 0; bj < 2; ++bj) xo[ai][m][bj] = *(const u32x4*)(base + (size_t)(ai * 128 + m * 16) * D + bj * 128);
#pragma unroll
        for (int ai = 0; ai < 2; ++ai)
#pragma unroll
            for (int m = 0; m < 4; ++m) { const int row = row0 + ai * 128 + m * 16; bf16_t* rp = base + (size_t)(ai * 128 + m * 16) * D; float sq = 0.f;
#pragma unroll
                for (int bj = 0; bj < 2; ++bj) { const u32x4 xv = xo[ai][m][bj];
                    const f32x4 a = acc[ai][bj][m][0], b = acc[ai][bj][m][1];
                    u32x4 w; w.x = pk2(bflo(xv.x) + alpha * a[0], bfhi(xv.x) + alpha * a[1]); w.y = pk2(bflo(xv.y) + alpha * a[2], bfhi(xv.y) + alpha * a[3]);
                    w.z = pk2(bflo(xv.z) + alpha * b[0], bfhi(xv.z) + alpha * b[1]); w.w = pk2(bflo(xv.w) + alpha * b[2], bfhi(xv.w) + alpha * b[3]);
                    *(u32x4*)(rp + bj * 128) = w;
                    sq += bflo(w.x) * bflo(w.x) + bfhi(w.x) * bfhi(w.x) + bflo(w.y) * bflo(w.y) + bfhi(w.y) * bfhi(w.y)
                        + bflo(w.z) * bflo(w.z) + bfhi(w.z) * bfhi(w.z) + bflo(w.w) * bflo(w.w) + bfhi(w.w) * bfhi(w.w); }
                sq += __int_as_float(__builtin_amdgcn_ds_bpermute((lane ^ 16) << 2, __float_as_int(sq)));
                sq += __int_as_float(__builtin_amdgcn_ds_bpermute((lane ^ 32) << 2, __float_as_int(sq)));
                if (fq == 0) atomicAdd(ssn + row, (u64)(unsigned)(sq * SS_SCALE)); }
    }
};
struct EpiBf16 { static constexpr bool PERM = true, HOOK = false; bf16_t* O; int ldc; const u64* ss;
    DI void operator()(const Acc& acc, const Unit& u, int wr, int wc, int fr, int fq) const {
        const int row0 = u.pm * 256 + wr * 64 + fr, col0 = u.pn * 256 + wc * 32 + 8 * fq;
#pragma unroll
        for (int ai = 0; ai < 2; ++ai)
#pragma unroll
            for (int m = 0; m < 4; ++m) { bf16_t* p = O + (size_t)(row0 + ai * 128 + m * 16) * ldc + col0;
                const float rs = ss ? rsqrtf((float)ss[row0 + ai * 128 + m * 16] * SS_INV + EPS) : 1.f;
#pragma unroll
                for (int bj = 0; bj < 2; ++bj) { const f32x4 a = acc[ai][bj][m][0] * rs, b = acc[ai][bj][m][1] * rs;
                    u32x4 w; w.x = pk2(a[0], a[1]); w.y = pk2(a[2], a[3]); w.z = pk2(b[0], b[1]); w.w = pk2(b[2], b[3]); *(u32x4*)(p + bj * 128) = w; } }
    }
};
DI void store_t(bf16_t* vt, size_t rowlen, int dcol0, int pos, const f32x4& a, const f32x4& b) {
#pragma unroll
    for (int i = 0; i < 4; ++i) { vt[(size_t)(dcol0 + i) * rowlen + pos] = (bf16_t)(pk2(a[i], 0.f) & 0xffffu); vt[(size_t)(dcol0 + 4 + i) * rowlen + pos] = (bf16_t)(pk2(b[i], 0.f) & 0xffffu); }
}
struct EpiSoftmax { static constexpr bool PERM = true, HOOK = false; bf16_t* P; const u64* ss; LAS float* xch;
    DI void operator()(Acc& acc, const Unit& u, int wr, int wc, int fr, int fq) const {
        const int rl0 = wr * 64 + fr, col0 = u.pn * 256 + wc * 32 + 8 * fq, lane = fq * 16 + fr;
        LAS float* rmax = xch; LAS float* rsum = xch + 1024;
        const float SCL = 0.0625f * LOG2E;
#pragma unroll
        for (int ai = 0; ai < 2; ++ai)
#pragma unroll
            for (int m = 0; m < 4; ++m) { const int rl = rl0 + ai * 128 + m * 16;
                const float rs = rsqrtf((float)ss[u.pm * 256 + rl] * SS_INV + EPS) * SCL; float mx = -3.0e38f;
#pragma unroll
                for (int bj = 0; bj < 2; ++bj)
#pragma unroll
                    for (int n = 0; n < 2; ++n) { acc[ai][bj][m][n] = acc[ai][bj][m][n] * rs;
                        mx = fmaxf(fmaxf(mx, fmaxf(acc[ai][bj][m][n][0], acc[ai][bj][m][n][1])), fmaxf(acc[ai][bj][m][n][2], acc[ai][bj][m][n][3])); }
                mx = fmaxf(mx, __int_as_float(__builtin_amdgcn_ds_bpermute((lane ^ 16) << 2, __float_as_int(mx))));
                mx = fmaxf(mx, __int_as_float(__builtin_amdgcn_ds_bpermute((lane ^ 32) << 2, __float_as_int(mx))));
                if (fq == 0) rmax[rl * 4 + wc] = mx; }
        asm volatile("s_waitcnt lgkmcnt(0)" ::: "memory"); __builtin_amdgcn_s_barrier(); asm volatile("" ::: "memory");
#pragma unroll
        for (int ai = 0; ai < 2; ++ai)
#pragma unroll
            for (int m = 0; m < 4; ++m) { const int rl = rl0 + ai * 128 + m * 16;
                const f32x4 m4 = *(const LAS f32x4*)(rmax + rl * 4); const float mx = fmaxf(fmaxf(m4[0], m4[1]), fmaxf(m4[2], m4[3])); float sm = 0.f;
#pragma unroll
                for (int bj = 0; bj < 2; ++bj)
#pragma unroll
                    for (int n = 0; n < 2; ++n)
#pragma unroll
                        for (int i = 0; i < 4; ++i) { const float p = __builtin_amdgcn_exp2f(acc[ai][bj][m][n][i] - mx); acc[ai][bj][m][n][i] = p; sm += p; }
                sm += __int_as_float(__builtin_amdgcn_ds_bpermute((lane ^ 16) << 2, __float_as_int(sm)));
                sm += __int_as_float(__builtin_amdgcn_ds_bpermute((lane ^ 32) << 2, __float_as_int(sm)));
                if (fq == 0) rsum[rl * 4 + wc] = sm; }
        asm volatile("s_waitcnt lgkmcnt(0)" ::: "memory"); __builtin_amdgcn_s_barrier(); asm volatile("" ::: "memory");
#pragma unroll
        for (int ai = 0; ai < 2; ++ai)
#pragma unroll
            for (int m = 0; m < 4; ++m) { const int rl = rl0 + ai * 128 + m * 16;
                const f32x4 s4 = *(const LAS f32x4*)(rsum + rl * 4); const float inv = 1.f / ((s4[0] + s4[1]) + (s4[2] + s4[3]));
                bf16_t* p = P + (size_t)(u.pm * 256 + rl) * D + col0;
#pragma unroll
                for (int bj = 0; bj < 2; ++bj) { const f32x4 a = acc[ai][bj][m][0] * inv, b = acc[ai][bj][m][1] * inv;
                    u32x4 w; w.x = pk2(a[0], a[1]); w.y = pk2(a[2], a[3]); w.z = pk2(b[0], b[1]); w.w = pk2(b[2], b[3]); *(u32x4*)(p + bj * 128) = w; } }
        asm volatile("s_waitcnt lgkmcnt(0)" ::: "memory"); __builtin_amdgcn_s_barrier(); asm volatile("" ::: "memory");
    }
};
struct EpiWin { static constexpr bool PERM = true, HOOK = false; bf16_t* U; bf16_t* KFB; bf16_t* KFC; bf16_t* VFB; bf16_t* VFC; bf16_t* GB; const u64* ss;
    DI void operator()(const Acc& acc_in, const Unit& u, int wr, int wc, int fr, int fq) const {
        const int rl0 = wr * 64 + fr, cl0 = wc * 32 + 8 * fq, pn = u.pn;
        Acc acc;
#pragma unroll
        for (int ai = 0; ai < 2; ++ai)
#pragma unroll
            for (int m = 0; m < 4; ++m) { const float rs = rsqrtf((float)ss[u.pm * 256 + rl0 + ai * 128 + m * 16] * SS_INV + EPS);
#pragma unroll
                for (int bj = 0; bj < 2; ++bj)
#pragma unroll
                    for (int n = 0; n < 2; ++n) acc[ai][bj][m][n] = acc_in[ai][bj][m][n] * rs; }
        const int bb = u.pm >> 4, s0 = (u.pm & 15) * 256;
        if (pn < 2) {
#pragma unroll
            for (int ai = 0; ai < 2; ++ai)
#pragma unroll
                for (int m = 0; m < 4; ++m) { bf16_t* p = U + (size_t)(u.pm * 256 + rl0 + ai * 128 + m * 16) * UP + UC_Z + pn * 128 + cl0; float v[8];
#pragma unroll
                    for (int n = 0; n < 2; ++n)
#pragma unroll
                        for (int i = 0; i < 4; ++i) v[n * 4 + i] = acc[ai][0][m][n][i] * sigm(acc[ai][1][m][n][i]);
                    u32x4 w; w.x = pk2(v[0], v[1]); w.y = pk2(v[2], v[3]); w.z = pk2(v[4], v[5]); w.w = pk2(v[6], v[7]); *(u32x4*)p = w; }
        } else if (pn == 4 || pn == 6 || pn == 7) {
            const int s4k = (wc & 1) * 2 + (fq >> 1), hik = fq & 1;
#pragma unroll
            for (int ai = 0; ai < 2; ++ai)
#pragma unroll
                for (int m = 0; m < 4; ++m) {
                    const int tokb = s0 + ai * 128 + wr * 64 + m * 16, chunk = tokb >> 5, r32k = (tokb & 31) + fr;
                    const int slot = tslot(fr), hiv = slot >> 3, iv = slot & 7, jv = m & 1;
#pragma unroll
                    for (int bj = 0; bj < 2; ++bj) {
                        const f32x4 a = acc[ai][bj][m][0], b = acc[ai][bj][m][1];
                        const bool isK = (pn == 6) || (pn == 4 && bj == 0);
                        if (isK) {
                            const int bh = (pn == 4) ? (bb * 2 + (wc >> 1)) : (bb * 4 + bj * 2 + (wc >> 1));
                            bf16_t* dst = (pn == 4 ? KFB : KFC) + ((size_t)(bh * 128 + chunk) * 4 + s4k) * 512 + (hik * 32 + r32k) * 8;
                            u32x4 w; w.x = pk2(a[0], a[1]); w.y = pk2(a[2], a[3]); w.z = pk2(b[0], b[1]); w.w = pk2(b[2], b[3]); *(u32x4*)dst = w;
                        } else {
                            const int bh = (pn == 4) ? (bb * 2 + (wc >> 1)) : (bb * 4 + bj * 2 + (wc >> 1));
                            const int dtv = wc & 1, dr0 = 8 * fq;
                            bf16_t* dst = (pn == 4 ? VFB : VFC) + (((size_t)(bh * 128 + chunk) * 2 + dtv) * 2 + jv) * 512 + (hiv * 32 + dr0) * 8 + iv;
#pragma unroll
                            for (int i = 0; i < 4; ++i) { dst[i * 8] = (bf16_t)(pk2(a[i], 0.f) & 0xffffu); dst[(4 + i) * 8] = (bf16_t)(pk2(b[i], 0.f) & 0xffffu); }
                        } } }
        } else if (pn >= 8) {
            bf16_t* gp = GB + ((size_t)(((pn - 8) >> 2) * 128 + u.pm) * 4 + ((pn - 8) & 3)) * 65536 + (size_t)(wr * 4 + wc) * 8192 + (fq * 16 + fr) * 8;
#pragma unroll
            for (int ai = 0; ai < 2; ++ai)
#pragma unroll
                for (int m = 0; m < 4; ++m)
#pragma unroll
                    for (int bj = 0; bj < 2; ++bj) { const f32x4 a = acc[ai][bj][m][0], b = acc[ai][bj][m][1];
                        u32x4 w; w.x = pk2(einv(a[0]), einv(a[1])); w.y = pk2(einv(a[2]), einv(a[3])); w.z = pk2(einv(b[0]), einv(b[1])); w.w = pk2(einv(b[2]), einv(b[3]));
                        *(u32x4*)(gp + (ai * 8 + m * 2 + bj) * 512) = w; }
        } else {
            const bool gate = false;
            const int uc = pn == 2 ? UC_BQ : pn == 3 ? UC_BQ + 256 : UC_CQ;
#pragma unroll
            for (int ai = 0; ai < 2; ++ai)
#pragma unroll
                for (int m = 0; m < 4; ++m) { bf16_t* p = U + (size_t)(u.pm * 256 + rl0 + ai * 128 + m * 16) * UP + uc + cl0;
#pragma unroll
                    for (int bj = 0; bj < 2; ++bj) { f32x4 a = acc[ai][bj][m][0], b = acc[ai][bj][m][1];
                        if (gate) {
#pragma unroll
                            for (int i = 0; i < 4; ++i) { a[i] = sigm(a[i]); b[i] = sigm(b[i]); } }
                        u32x4 w; w.x = pk2(a[0], a[1]); w.y = pk2(a[2], a[3]); w.z = pk2(b[0], b[1]); w.w = pk2(b[2], b[3]); *(u32x4*)(p + bj * 128) = w; } }
        }
    }
};
DI void unpack8(const u32x4 w, float (&g)[8]) { g[0] = bflo(w.x); g[1] = bfhi(w.x); g[2] = bflo(w.y); g[3] = bfhi(w.y); g[4] = bflo(w.z); g[5] = bfhi(w.z); g[6] = bflo(w.w); g[7] = bfhi(w.w); }
struct EpiYF { static constexpr bool PERM = true, HOOK = true; bf16_t* Y; const bf16_t* GB;
    DI const bf16_t* gtile(int br, const Unit& u, int wr, int wc, int fr, int fq) const { return GB + ((size_t)(br * 128 + u.pm) * 4 + u.pn) * 65536 + (size_t)(wr * 4 + wc) * 8192 + (fq * 16 + fr) * 8; }
    DI void hook(Acc& acc, const Unit& u, int t, int wr, int wc, int fr, int fq) const {
        const int br = (t == 4) ? 0 : 1;
        const bf16_t* gn = gtile(br, u, wr, wc, fr, fq); const bf16_t* gd = gtile(br + 1, u, wr, wc, fr, fq);
#pragma unroll
        for (int ai = 0; ai < 2; ++ai) {
            u32x4 wn[8], wd[8];
#pragma unroll
            for (int f = 0; f < 8; ++f) { wn[f] = *(const u32x4*)(gn + (ai * 8 + f) * 512); wd[f] = *(const u32x4*)(gd + (ai * 8 + f) * 512); }
#pragma unroll
            for (int m = 0; m < 4; ++m)
#pragma unroll
                for (int bj = 0; bj < 2; ++bj) { float a[8], b[8]; unpack8(wn[m * 2 + bj], a); unpack8(wd[m * 2 + bj], b);
#pragma unroll
                    for (int i = 0; i < 4; ++i) { acc[ai][bj][m][0][i] *= b[i] * __builtin_amdgcn_rcpf(a[i]);
                                                  acc[ai][bj][m][1][i] *= b[4 + i] * __builtin_amdgcn_rcpf(a[4 + i]); } }
            asm volatile("" ::: "memory"); }
    }
    DI void operator()(const Acc& acc, const Unit& u, int wr, int wc, int fr, int fq) const {
        const int row0 = u.pm * 256 + wr * 64 + fr, col0 = u.pn * 256 + wc * 32 + 8 * fq;
        const bf16_t* gc = gtile(2, u, wr, wc, fr, fq);
#pragma unroll
        for (int ai = 0; ai < 2; ++ai) {
            u32x4 wg[8];
#pragma unroll
            for (int f = 0; f < 8; ++f) wg[f] = *(const u32x4*)(gc + (ai * 8 + f) * 512);
#pragma unroll
            for (int m = 0; m < 4; ++m) { bf16_t* rp = Y + (size_t)(row0 + ai * 128 + m * 16) * D + col0;
#pragma unroll
                for (int bj = 0; bj < 2; ++bj) { float g[8]; unpack8(wg[m * 2 + bj], g);
                    const f32x4 a = acc[ai][bj][m][0], b = acc[ai][bj][m][1];
                    u32x4 w; w.x = pk2(a[0] * __builtin_amdgcn_rcpf(g[0]), a[1] * __builtin_amdgcn_rcpf(g[1])); w.y = pk2(a[2] * __builtin_amdgcn_rcpf(g[2]), a[3] * __builtin_amdgcn_rcpf(g[3]));
                    w.z = pk2(b[0] * __builtin_amdgcn_rcpf(g[4]), b[1] * __builtin_amdgcn_rcpf(g[5])); w.w = pk2(b[2] * __builtin_amdgcn_rcpf(g[6]), b[3] * __builtin_amdgcn_rcpf(g[7]));
                    *(u32x4*)(rp + bj * 128) = w; } }
            asm volatile("" ::: "memory"); }
    }
};

DI float shx(float v, int o, int lane) { return __int_as_float(__builtin_amdgcn_ds_bpermute((lane ^ o) << 2, __float_as_int(v))); }
DI float xh_max(float m) { const auto rr = __builtin_amdgcn_permlane32_swap(__float_as_uint(m), __float_as_uint(m), false, false); return fmaxf(__uint_as_float(rr[0]), __uint_as_float(rr[1])); }
DI float xh_sum(float m) { const auto rr = __builtin_amdgcn_permlane32_swap(__float_as_uint(m), __float_as_uint(m), false, false); return __uint_as_float(rr[0]) + __uint_as_float(rr[1]); }
DI float wave_sum(float v, int lane) {
#pragma unroll
    for (int o = 1; o < 64; o <<= 1) v += shx(v, o, lane);
    return v;
}
DI void transpose_item(const float* W, int K, int N, bf16_t* WT, int mode, LAS float* scr, int item, int lane, const float* gain = nullptr, int ldw = 0) {
    if (ldw == 0) ldw = K;
    const int nblk = N / 32, kb = item / nblk, nb = item % nblk, k0 = 64 * kb, n0 = 32 * nb;
    int rowbase = n0;
    if (mode == 1) rowbase = 256 * (n0 >> 7) + (n0 & 127);
    else if (mode == 2) rowbase = 256 * (n0 >> 7) + 128 + (n0 & 127);
    else if (mode == 3) { if (n0 < 256) rowbase = 256 * (n0 >> 7) + (n0 & 127); else if (n0 < 512) { const int j = n0 - 256; rowbase = 256 * (j >> 7) + 128 + (j & 127); } }
    float wv[32];
#pragma unroll
    for (int i = 0; i < 32; ++i) wv[i] = __builtin_nontemporal_load(&W[(size_t)(k0 + 2 * i + (lane >> 5)) * N + n0 + (lane & 31)]);
    if (gain) {
#pragma unroll
        for (int i = 0; i < 32; ++i) wv[i] *= gain[k0 + 2 * i + (lane >> 5)]; }
#pragma unroll
    for (int i = 0; i < 32; ++i) scr[(2 * i + (lane >> 5)) * 33 + (lane & 31)] = wv[i];
    asm volatile("s_waitcnt lgkmcnt(0)" ::: "memory");
    const int c = lane & 7;
#pragma unroll
    for (int j = 0; j < 4; ++j) { const int n = (lane >> 3) + 8 * j; const LAS float* s = scr + (8 * c) * 33 + n;
        u32x4 o; o.x = pk2(s[0 * 33], s[1 * 33]); o.y = pk2(s[2 * 33], s[3 * 33]); o.z = pk2(s[4 * 33], s[5 * 33]); o.w = pk2(s[6 * 33], s[7 * 33]);
        *(u32x4*)(WT + (size_t)(rowbase + n) * ldw + k0 + 8 * c) = o; }
    asm volatile("s_waitcnt lgkmcnt(0)" ::: "memory");
}
DI void rms_row_bf16(const float* xrow, const float* g, bf16_t* orow, int lane) {
    const f32x4* xr = (const f32x4*)xrow + lane; const f32x4* gr = (const f32x4*)g + lane;
    f32x4 v[4]; float s = 0.f;
#pragma unroll
    for (int j = 0; j < 4; ++j) { v[j] = xr[64 * j]; s += (v[j].x * v[j].x + v[j].y * v[j].y) + (v[j].z * v[j].z + v[j].w * v[j].w); }
    const float rstd = 1.f / sqrtf(wave_sum(s, lane) * (1.f / D) + EPS);
    u32x2* o8 = (u32x2*)orow + lane;
#pragma unroll
    for (int j = 0; j < 4; ++j) { const f32x4 gg = gr[64 * j]; u32x2 w; w.x = pk2(v[j].x * rstd * gg.x, v[j].y * rstd * gg.y); w.y = pk2(v[j].z * rstd * gg.z, v[j].w * rstd * gg.w); o8[64 * j] = w; }
}
DI void norm_phase(const float* X, const float* g, bf16_t* XN, int gw, int ngw, int lane) {
    for (int m = gw; m < M; m += ngw) rms_row_bf16(X + (size_t)m * D, g, XN + (size_t)m * D, lane);
}

DI void conv_unit(LAS unsigned char* lds, const bf16_t* U, bf16_t* MIX, const float* dw_w, const float* dw_b, const float* ln_g, const float* ln_b, int b, int tc, int tid, int wid, int lane) {
    LAS bf16_t* zt = (LAS bf16_t*)lds;
    LAS float* cv = (LAS float*)(lds + 49152);
    const int tok0 = tc * 64;
    {
        u32x4 v[6];
#pragma unroll
        for (int i = 0; i < 6; ++i) { const int row = (tid >> 5) + 16 * i, t = tok0 - 15 + row; v[i] = (u32x4){0u, 0u, 0u, 0u};
            if (row < 94 && t >= 0 && t < SEQ) v[i] = *(const u32x4*)(U + (size_t)(b * SEQ + t) * UP + UC_Z + (tid & 31) * 8); }
#pragma unroll
        for (int i = 0; i < 6; ++i) { const int row = (tid >> 5) + 16 * i; if (row < 94) *(LAS u32x4*)(zt + row * 256 + (tid & 31) * 8) = v[i]; }
    }
    __syncthreads();
    {
        const int c = tid & 255, half = tid >> 8;
        float w[31];
#pragma unroll
        for (int j = 0; j < 31; ++j) w[j] = dw_w[j * 256 + c];
        const float bias = dw_b[c];
#pragma unroll 1
        for (int pass = 0; pass < 2; ++pass) {
            const int tl0 = half * 32 + pass * 16;
            float zv[46];
#pragma unroll
            for (int i = 0; i < 46; ++i) zv[i] = __uint_as_float((unsigned)zt[(tl0 + i) * 256 + c] << 16);
#pragma unroll
            for (int t = 0; t < 16; ++t) { float a = bias;
#pragma unroll
                for (int j = 0; j < 31; ++j) a += zv[t + j] * w[j];
                cv[(tl0 + t) * 256 + c] = a; }
        }
    }
    __syncthreads();
    {
        const f32x4 g4 = *(const f32x4*)(ln_g + lane * 4), b4 = *(const f32x4*)(ln_b + lane * 4);
        f32x4 x[8]; float s[8];
#pragma unroll
        for (int i = 0; i < 8; ++i) { x[i] = *(const LAS f32x4*)(cv + (wid + 8 * i) * 256 + lane * 4); s[i] = (x[i].x + x[i].y) + (x[i].z + x[i].w); }
#pragma unroll
        for (int o = 1; o < 64; o <<= 1)
#pragma unroll
            for (int i = 0; i < 8; ++i) s[i] += shx(s[i], o, lane);
#pragma unroll
        for (int i = 0; i < 8; ++i) { x[i] = x[i] - s[i] * (1.f / 256.f); s[i] = (x[i].x * x[i].x + x[i].y * x[i].y) + (x[i].z * x[i].z + x[i].w * x[i].w); }
#pragma unroll
        for (int o = 1; o < 64; o <<= 1)
#pragma unroll
            for (int i = 0; i < 8; ++i) s[i] += shx(s[i], o, lane);
#pragma unroll
        for (int i = 0; i < 8; ++i) { const int tl = wid + 8 * i; const float rstd = 1.f / sqrtf(s[i] * (1.f / 256.f) + EPS);
            f32x4 y = x[i] * rstd * g4 + b4;
            y.x *= sigm(y.x); y.y *= sigm(y.y); y.z *= sigm(y.z); y.w *= sigm(y.w);
            u32x2 o; o.x = pk2(y.x, y.y); o.y = pk2(y.z, y.w);
            *(u32x2*)(MIX + (size_t)(b * SEQ + tok0 + tl) * D + lane * 4) = o; }
    }
    __syncthreads();
}

#define MFMA32(a, b, c) __builtin_amdgcn_mfma_f32_32x32x16_bf16((a), (b), (c), 0, 0, 0)
template <int MODE>
DI void attn_unit(const bf16_t* __restrict__ U, const bf16_t* __restrict__ KF, const bf16_t* __restrict__ VF, bf16_t* __restrict__ MIX, const LAS float* tab, int b, int st, int h, int lane, float sink2) {
    const int r32 = lane & 31, hi = lane >> 5, q0 = st * 32;
    constexpr int QCOL = MODE ? UC_CQ : UC_BQ, OCOL = MODE ? 768 : 256, NKH = MODE ? 4 : 2, NCH = MODE ? 16 : 9;
    const int kh = MODE ? h : (h >> 2);
    const bf16_t* qp = U + (size_t)(b * SEQ + q0 + r32) * UP + QCOL + h * 64 + 8 * hi;
    bf16x8 qf[4];
#pragma unroll
    for (int s = 0; s < 4; ++s) qf[s] = *(const bf16x8*)(qp + 16 * s);
    const bf16_t* kbase = KF + (size_t)(b * NKH + kh) * (SEQ * 64) + lane * 8;
    const bf16_t* vbase = VF + (size_t)(b * NKH + kh) * (SEQ * 64) + lane * 8;
    float mrun = MODE ? -30000.f : sink2, l = 0.f;
    f32x16 o0, o1;
#pragma unroll
    for (int r = 0; r < 16; ++r) { o0[r] = 0.f; o1[r] = 0.f; }
    const float SC = 0.125f * LOG2E;
    const int qrow = q0 >> 6, rs = min(max(qrow - 4, 0), 56);
    const int qc = (q0 & 63) + r32, cs = min(max(qc - 8, 0), 48);
    bf16x8 kf[3][4], vf[3][4];
#define KV0(c) (MODE ? ((rs + ((c) >> 1)) * 64 + ((c) & 1) * 32) : (q0 - 128 + 32 * (c)))
#define LOADKV(slot, c) do { const int kvc_ = min(max(KV0(c), 0), SEQ - 32); const bf16_t* kp_ = kbase + (size_t)(kvc_ >> 5) * 2048; const bf16_t* vp_ = vbase + (size_t)(kvc_ >> 5) * 2048; \
        _Pragma("unroll") for (int s4 = 0; s4 < 4; ++s4) { kf[slot][s4] = *(const bf16x8*)(kp_ + 512 * s4); vf[slot][s4] = *(const bf16x8*)(vp_ + 512 * s4); } } while (0)
    LOADKV(0, 0); LOADKV(1, 1);
    auto chunk = [&](const int c, auto slot_c, auto pslot_c) __attribute__((always_inline)) {
        constexpr int SLOT = decltype(slot_c)::value, PSLOT = decltype(pslot_c)::value;
        if (c + 2 < NCH) LOADKV(PSLOT, c + 2);
        const int kv0 = KV0(c);
        if (c >= NCH || (MODE == 0 && (kv0 < 0 || kv0 >= SEQ))) return;
        f32x16 s;
#pragma unroll
        for (int r = 0; r < 16; ++r) s[r] = 0.f;
#pragma unroll
        for (int s4 = 0; s4 < 4; ++s4) s = MFMA32(kf[SLOT][s4], qf[s4], s);
        float t[16];
        if (MODE == 0) {
            const int base = kv0 - q0 + 4 * hi - r32 + 128;
            if (c == 0 || c == NCH - 1) {
#pragma unroll
                for (int r = 0; r < 16; ++r) { const int idx = base + (r & 3) + 8 * (r >> 2); const bool ok = (unsigned)idx <= 256u;
                    const float bv = tab[h * 257 + (ok ? idx : 0)]; t[r] = ok ? s[r] * SC + bv : -1e30f; }
            } else {
#pragma unroll
                for (int r = 0; r < 16; ++r) t[r] = s[r] * SC + tab[h * 257 + base + (r & 3) + 8 * (r >> 2)];
            }
        } else {
            const int kcb = (kv0 & 63) + 4 * hi, drow = (kv0 >> 6) - qrow;
            const LAS float* tp = tab + (h * 15 + drow + 7) * 31 + 15 - qc + kcb;
            const int rel0 = kcb - cs;
#pragma unroll
            for (int r = 0; r < 16; ++r) { const bool ok = (unsigned)(rel0 + (r & 3) + 8 * (r >> 2)) < 16u;
                const float bv = tp[(r & 3) + 8 * (r >> 2)]; t[r] = ok ? s[r] * SC + bv : -1e30f; }
        }
        float mx = t[0];
#pragma unroll
        for (int r = 1; r < 16; ++r) mx = fmaxf(mx, t[r]);
        mx = xh_max(mx);
        const float mnew = fmaxf(mrun, mx), alpha = __builtin_amdgcn_exp2f(mrun - mnew);
        mrun = mnew;
        float ps = 0.f;
#pragma unroll
        for (int r = 0; r < 16; ++r) { t[r] = __builtin_amdgcn_exp2f(t[r] - mnew); ps += t[r]; }
        l = l * alpha + ps;
#pragma unroll
        for (int r = 0; r < 16; ++r) { o0[r] *= alpha; o1[r] *= alpha; }
        u32x4 w0, w1;
        w0.x = pk2(t[0], t[1]); w0.y = pk2(t[2], t[3]); w0.z = pk2(t[4], t[5]); w0.w = pk2(t[6], t[7]);
        w1.x = pk2(t[8], t[9]); w1.y = pk2(t[10], t[11]); w1.z = pk2(t[12], t[13]); w1.w = pk2(t[14], t[15]);
        const bf16x8 pb0 = __builtin_bit_cast(bf16x8, w0), pb1 = __builtin_bit_cast(bf16x8, w1);
        o0 = MFMA32(vf[SLOT][0], pb0, o0); o0 = MFMA32(vf[SLOT][1], pb1, o0);
        o1 = MFMA32(vf[SLOT][2], pb0, o1); o1 = MFMA32(vf[SLOT][3], pb1, o1);
        };
#pragma unroll 1
    for (int c3 = 0; c3 < NCH; c3 += 3) {
        chunk(c3, std::integral_constant<int, 0>{}, std::integral_constant<int, 2>{});
        chunk(c3 + 1, std::integral_constant<int, 1>{}, std::integral_constant<int, 0>{});
        chunk(c3 + 2, std::integral_constant<int, 2>{}, std::integral_constant<int, 1>{});
    }
#undef KV0
#undef LOADKV
    l = xh_sum(l);
    const float den = l + (MODE ? 0.f : __builtin_amdgcn_exp2f(sink2 - mrun));
    const float inv = 1.f / den;
    bf16_t* op = MIX + (size_t)(b * SEQ + q0 + r32) * D + OCOL + h * 64 + 4 * hi;
#pragma unroll
    for (int g = 0; g < 4; ++g) {
        u32x2 a; a.x = pk2(o0[4 * g] * inv, o0[4 * g + 1] * inv); a.y = pk2(o0[4 * g + 2] * inv, o0[4 * g + 3] * inv); *(u32x2*)(op + 8 * g) = a;
        u32x2 c; c.x = pk2(o1[4 * g] * inv, o1[4 * g + 1] * inv); c.y = pk2(o1[4 * g + 2] * inv, o1[4 * g + 3] * inv); *(u32x2*)(op + 32 + 8 * g) = c; }
}

DI void na_row_unit(const bf16_t* __restrict__ U, const bf16_t* __restrict__ KF, const bf16_t* __restrict__ VF, bf16_t* __restrict__ MIX, const LAS float* tab, int b, int qrow, int h, int lane) {
    const int r32 = lane & 31, hi = lane >> 5;
    const bf16_t* qp = U + (size_t)(b * SEQ + qrow * 64 + r32) * UP + UC_CQ + h * 64 + 8 * hi;
    bf16x8 qf[2][4];
#pragma unroll
    for (int sb = 0; sb < 2; ++sb)
#pragma unroll
        for (int s = 0; s < 4; ++s) qf[sb][s] = *(const bf16x8*)(qp + (size_t)sb * 32 * UP + 16 * s);
    const bf16_t* kbase = KF + (size_t)(b * 4 + h) * (SEQ * 64) + lane * 8;
    const bf16_t* vbase = VF + (size_t)(b * 4 + h) * (SEQ * 64) + lane * 8;
    float mrun[2] = {-30000.f, -30000.f}, l[2] = {0.f, 0.f};
    f32x16 o[2][2];
#pragma unroll
    for (int sb = 0; sb < 2; ++sb)
#pragma unroll
        for (int r = 0; r < 16; ++r) { o[sb][0][r] = 0.f; o[sb][1][r] = 0.f; }
    const float SC = 0.125f * LOG2E;
    const int rs = min(max(qrow - 4, 0), 56);
    bf16x8 kf[2][4], vf[2][4];
#define NLOAD(slot, c) do { const bf16_t* kp_ = kbase + (size_t)((rs + ((c) >> 1)) * 2 + ((c) & 1)) * 2048; const bf16_t* vp_ = vbase + (size_t)((rs + ((c) >> 1)) * 2 + ((c) & 1)) * 2048; \
        _Pragma("unroll") for (int s4 = 0; s4 < 4; ++s4) { kf[slot][s4] = *(const bf16x8*)(kp_ + 512 * s4); vf[slot][s4] = *(const bf16x8*)(vp_ + 512 * s4); } } while (0)
    NLOAD(0, 0);
    auto chunk = [&](const int c, auto slot_c) __attribute__((always_inline)) {
        constexpr int SLOT = decltype(slot_c)::value;
        if (c + 1 < 16) NLOAD(SLOT ^ 1, c + 1);
        const int kcb = (c & 1) * 32 + 4 * hi, drow = rs + (c >> 1) - qrow;
#pragma unroll
        for (int sb = 0; sb < 2; ++sb) {
            const int qc = sb * 32 + r32, cs = min(max(qc - 8, 0), 48);
            f32x16 s;
#pragma unroll
            for (int r = 0; r < 16; ++r) s[r] = 0.f;
#pragma unroll
            for (int s4 = 0; s4 < 4; ++s4) s = MFMA32(kf[SLOT][s4], qf[sb][s4], s);
            if (SLOT != sb) {
                const LAS float* tp = tab + (h * 15 + drow + 7) * 31 + 15 - qc + kcb;
                const int rel0 = kcb - cs, R0 = sb ? 12 : 0;
                float t4[4];
#pragma unroll
                for (int i = 0; i < 4; ++i) { const int r = R0 + i; const bool ok = (unsigned)(rel0 + (r & 3) + 8 * (r >> 2)) < 16u;
                    const float bv = tp[(r & 3) + 8 * (r >> 2)]; t4[i] = ok ? s[r] * SC + bv : -1e30f; }
                float mx = fmaxf(fmaxf(t4[0], t4[1]), fmaxf(t4[2], t4[3]));
                mx = xh_max(mx);
                if (__builtin_amdgcn_ballot_w64(mx > mrun[sb] + 8.f) != 0ull) {
                    const float mnew = fmaxf(mrun[sb], mx), alpha = __builtin_amdgcn_exp2f(mrun[sb] - mnew);
                    mrun[sb] = mnew; l[sb] *= alpha;
#pragma unroll
                    for (int r = 0; r < 16; ++r) { o[sb][0][r] *= alpha; o[sb][1][r] *= alpha; } }
                const float mref = mrun[sb];
                float ps = 0.f;
#pragma unroll
                for (int i = 0; i < 4; ++i) { t4[i] = __builtin_amdgcn_exp2f(t4[i] - mref); ps += t4[i]; }
                l[sb] += ps;
                u32x4 w; w.x = 0u; w.y = 0u; w.z = 0u; w.w = 0u;
                if (sb == 0) { w.x = pk2(t4[0], t4[1]); w.y = pk2(t4[2], t4[3]); } else { w.z = pk2(t4[0], t4[1]); w.w = pk2(t4[2], t4[3]); }
                const bf16x8 pb = __builtin_bit_cast(bf16x8, w);
                o[sb][0] = MFMA32(vf[SLOT][sb], pb, o[sb][0]);
                o[sb][1] = MFMA32(vf[SLOT][2 + sb], pb, o[sb][1]);
            } else {
                const LAS float* tp = tab + (h * 15 + drow + 7) * 31 + 15 - qc + kcb;
                const int rel0 = kcb - cs;
                float t[16];
#pragma unroll
                for (int r = 0; r < 16; ++r) { const bool ok = (unsigned)(rel0 + (r & 3) + 8 * (r >> 2)) < 16u;
                    const float bv = tp[(r & 3) + 8 * (r >> 2)]; t[r] = ok ? s[r] * SC + bv : -1e30f; }
                float mx = t[0];
#pragma unroll
                for (int r = 1; r < 16; ++r) mx = fmaxf(mx, t[r]);
                mx = xh_max(mx);
                if (__builtin_amdgcn_ballot_w64(mx > mrun[sb] + 8.f) != 0ull) {
                    const float mnew = fmaxf(mrun[sb], mx), alpha = __builtin_amdgcn_exp2f(mrun[sb] - mnew);
                    mrun[sb] = mnew; l[sb] *= alpha;
#pragma unroll
                    for (int r = 0; r < 16; ++r) { o[sb][0][r] *= alpha; o[sb][1][r] *= alpha; } }
                const float mref = mrun[sb];
                float ps = 0.f;
#pragma unroll
                for (int r = 0; r < 16; ++r) { t[r] = __builtin_amdgcn_exp2f(t[r] - mref); ps += t[r]; }
                l[sb] += ps;
                u32x4 w0, w1;
                w0.x = pk2(t[0], t[1]); w0.y = pk2(t[2], t[3]); w0.z = pk2(t[4], t[5]); w0.w = pk2(t[6], t[7]);
                w1.x = pk2(t[8], t[9]); w1.y = pk2(t[10], t[11]); w1.z = pk2(t[12], t[13]); w1.w = pk2(t[14], t[15]);
                const bf16x8 pb0 = __builtin_bit_cast(bf16x8, w0), pb1 = __builtin_bit_cast(bf16x8, w1);
                o[sb][0] = MFMA32(vf[SLOT][0], pb0, o[sb][0]); o[sb][0] = MFMA32(vf[SLOT][1], pb1, o[sb][0]);
                o[sb][1] = MFMA32(vf[SLOT][2], pb0, o[sb][1]); o[sb][1] = MFMA32(vf[SLOT][3], pb1, o[sb][1]);
            }
        }
    };
#pragma unroll 1
    for (int c2 = 0; c2 < 16; c2 += 2) {
        chunk(c2, std::integral_constant<int, 0>{});
        chunk(c2 + 1, std::integral_constant<int, 1>{});
    }
#undef NLOAD
#pragma unroll
    for (int sb = 0; sb < 2; ++sb) {
        float lt = xh_sum(l[sb]);
        const float inv = 1.f / lt;
        bf16_t* op = MIX + (size_t)(b * SEQ + qrow * 64 + sb * 32 + r32) * D + 768 + h * 64 + 4 * hi;
#pragma unroll
        for (int g = 0; g < 4; ++g) {
            u32x2 a; a.x = pk2(o[sb][0][4 * g] * inv, o[sb][0][4 * g + 1] * inv); a.y = pk2(o[sb][0][4 * g + 2] * inv, o[sb][0][4 * g + 3] * inv); *(u32x2*)(op + 8 * g) = a;
            u32x2 c; c.x = pk2(o[sb][1][4 * g] * inv, o[sb][1][4 * g + 1] * inv); c.y = pk2(o[sb][1][4 * g + 2] * inv, o[sb][1][4 * g + 3] * inv); *(u32x2*)(op + 32 + 8 * g) = c; }
    }
}

DI void win_pair_unit(const bf16_t* __restrict__ U, const bf16_t* __restrict__ KF, const bf16_t* __restrict__ VF, bf16_t* __restrict__ MIX, const LAS float* tab, int b, int st, int hp, int lane, float sinkA, float sinkB) {
    const int r32 = lane & 31, hi = lane >> 5, q0 = st * 32, h0 = hp * 2, kh = hp >> 1;
    const bf16_t* qp = U + (size_t)(b * SEQ + q0 + r32) * UP + UC_BQ + h0 * 64 + 8 * hi;
    bf16x8 qf[2][4];
#pragma unroll
    for (int hh = 0; hh < 2; ++hh)
#pragma unroll
        for (int s = 0; s < 4; ++s) qf[hh][s] = *(const bf16x8*)(qp + hh * 64 + 16 * s);
    const bf16_t* kbase = KF + (size_t)(b * 2 + kh) * (SEQ * 64) + lane * 8;
    const bf16_t* vbase = VF + (size_t)(b * 2 + kh) * (SEQ * 64) + lane * 8;
    float mrun[2] = {sinkA, sinkB}, l[2] = {0.f, 0.f};
    f32x16 o[2][2];
#pragma unroll
    for (int hh = 0; hh < 2; ++hh)
#pragma unroll
        for (int r = 0; r < 16; ++r) { o[hh][0][r] = 0.f; o[hh][1][r] = 0.f; }
    const float SC = 0.125f * LOG2E;
    bf16x8 kf[2][4], vf[2][4];
#define WLOAD(slot, c) do { const int kvc_ = min(max(q0 - 128 + 32 * (c), 0), SEQ - 32); const bf16_t* kp_ = kbase + (size_t)(kvc_ >> 5) * 2048; const bf16_t* vp_ = vbase + (size_t)(kvc_ >> 5) * 2048; \
        _Pragma("unroll") for (int s4 = 0; s4 < 4; ++s4) { kf[slot][s4] = *(const bf16x8*)(kp_ + 512 * s4); vf[slot][s4] = *(const bf16x8*)(vp_ + 512 * s4); } } while (0)
    WLOAD(0, 0);
    auto chunk = [&](const int c, auto slot_c) __attribute__((always_inline)) {
        constexpr int SLOT = decltype(slot_c)::value;
        if (c + 1 < 9) WLOAD(SLOT ^ 1, c + 1);
        const int kv0 = q0 - 128 + 32 * c;
        if (c >= 9 || kv0 < 0 || kv0 >= SEQ) return;
        const int base = kv0 - q0 + 4 * hi - r32 + 128;
#pragma unroll
        for (int hh = 0; hh < 2; ++hh) {
            f32x16 s;
#pragma unroll
            for (int r = 0; r < 16; ++r) s[r] = 0.f;
#pragma unroll
            for (int s4 = 0; s4 < 4; ++s4) s = MFMA32(kf[SLOT][s4], qf[hh][s4], s);
            const LAS float* tp = tab + (h0 + hh) * 257;
            float t[16];
            if (c == 0 || c == 8) {
#pragma unroll
                for (int r = 0; r < 16; ++r) { const int idx = base + (r & 3) + 8 * (r >> 2); const bool ok = (unsigned)idx <= 256u;
                    const float bv = tp[ok ? idx : 0]; t[r] = ok ? s[r] * SC + bv : -1e30f; }
            } else {
#pragma unroll
                for (int r = 0; r < 16; ++r) t[r] = s[r] * SC + tp[base + (r & 3) + 8 * (r >> 2)];
            }
            float mx = t[0];
#pragma unroll
            for (int r = 1; r < 16; ++r) mx = fmaxf(mx, t[r]);
            mx = xh_max(mx);
            if (__builtin_amdgcn_ballot_w64(mx > mrun[hh] + 8.f) != 0ull) {
                const float mnew = fmaxf(mrun[hh], mx), alpha = __builtin_amdgcn_exp2f(mrun[hh] - mnew);
                mrun[hh] = mnew; l[hh] *= alpha;
#pragma unroll
                for (int r = 0; r < 16; ++r) { o[hh][0][r] *= alpha; o[hh][1][r] *= alpha; } }
            const float mref = mrun[hh];
            float ps = 0.f;
#pragma unroll
            for (int r = 0; r < 16; ++r) { t[r] = __builtin_amdgcn_exp2f(t[r] - mref); ps += t[r]; }
            l[hh] += ps;
            u32x4 w0, w1;
            w0.x = pk2(t[0], t[1]); w0.y = pk2(t[2], t[3]); w0.z = pk2(t[4], t[5]); w0.w = pk2(t[6], t[7]);
            w1.x = pk2(t[8], t[9]); w1.y = pk2(t[10], t[11]); w1.z = pk2(t[12], t[13]); w1.w = pk2(t[14], t[15]);
            const bf16x8 pb0 = __builtin_bit_cast(bf16x8, w0), pb1 = __builtin_bit_cast(bf16x8, w1);
            o[hh][0] = MFMA32(vf[SLOT][0], pb0, o[hh][0]); o[hh][0] = MFMA32(vf[SLOT][1], pb1, o[hh][0]);
            o[hh][1] = MFMA32(vf[SLOT][2], pb0, o[hh][1]); o[hh][1] = MFMA32(vf[SLOT][3], pb1, o[hh][1]);
        }
    };
#pragma unroll 1
    for (int c2 = 0; c2 < 9; c2 += 2) {
        chunk(c2, std::integral_constant<int, 0>{});
        chunk(c2 + 1, std::integral_constant<int, 1>{});
    }
#undef WLOAD
#pragma unroll
    for (int hh = 0; hh < 2; ++hh) {
        float lt = xh_sum(l[hh]);
        const float inv = 1.f / (lt + __builtin_amdgcn_exp2f((hh ? sinkB : sinkA) - mrun[hh]));
        bf16_t* op = MIX + (size_t)(b * SEQ + q0 + r32) * D + 256 + (h0 + hh) * 64 + 4 * hi;
#pragma unroll
        for (int g = 0; g < 4; ++g) {
            u32x2 a; a.x = pk2(o[hh][0][4 * g] * inv, o[hh][0][4 * g + 1] * inv); a.y = pk2(o[hh][0][4 * g + 2] * inv, o[hh][0][4 * g + 3] * inv); *(u32x2*)(op + 8 * g) = a;
            u32x2 c; c.x = pk2(o[hh][1][4 * g] * inv, o[hh][1][4 * g + 1] * inv); c.y = pk2(o[hh][1][4 * g + 2] * inv, o[hh][1][4 * g + 3] * inv); *(u32x2*)(op + 32 + 8 * g) = c; }
    }
}

DI void cross_unit(LAS unsigned char* lds, const bf16_t* QX, const bf16_t* KX, const bf16_t* VXT, bf16_t* OX, int b, int h, int qb, int tid, int wid, int lane) {
    constexpr int PITCH = 528;
    const int r32 = lane & 31, hi = lane >> 5;
    const int q0 = qb * 256 + wid * 32;
    bf16x8 qf[16];
    {
        const bf16_t* qp = QX + (size_t)(b * SEQ + q0 + r32) * D + h * 256 + 8 * hi;
#pragma unroll
        for (int s = 0; s < 16; ++s) qf[s] = *(const bf16x8*)(qp + 16 * s);
        const bf16_t* kp0 = KX + (size_t)(b * 256 + (tid >> 5)) * D + h * 256 + (tid & 31) * 8;
        LAS unsigned char* l0 = lds + (tid >> 5) * PITCH + (tid & 31) * 16;
#pragma unroll
        for (int hf = 0; hf < 2; ++hf) { u32x4 kv[8];
#pragma unroll
            for (int i = 0; i < 8; ++i) kv[i] = *(const u32x4*)(kp0 + (size_t)(hf * 8 + i) * 16 * D);
#pragma unroll
            for (int i = 0; i < 8; ++i) *(LAS u32x4*)(l0 + (hf * 8 + i) * 16 * PITCH) = kv[i];
            asm volatile("" ::: "memory"); }
    }
    __syncthreads();
    bf16x8 pb[8][2]; float inv;
    {
        f32x16 S[8];
#pragma unroll
        for (int c = 0; c < 8; ++c) {
#pragma unroll
            for (int r = 0; r < 16; ++r) S[c][r] = 0.f;
#pragma unroll
            for (int s = 0; s < 16; ++s) { const bf16x8 kf = *(const LAS bf16x8*)(lds + (32 * c + r32) * PITCH + (16 * s + 8 * hi) * 2); S[c] = MFMA32(kf, qf[s], S[c]); }
        }
        float mx = S[0][0];
#pragma unroll
        for (int c = 0; c < 8; ++c)
#pragma unroll
            for (int r = 0; r < 16; ++r) mx = fmaxf(mx, S[c][r]);
        mx = xh_max(mx);
        const float SC = 0.0625f * LOG2E; float l = 0.f;
#pragma unroll
        for (int c = 0; c < 8; ++c) {
#pragma unroll
            for (int r = 0; r < 16; ++r) { const float p = __builtin_amdgcn_exp2f((S[c][r] - mx) * SC); S[c][r] = p; l += p; }
            u32x4 w0, w1;
            w0.x = pk2(S[c][0], S[c][1]); w0.y = pk2(S[c][2], S[c][3]); w0.z = pk2(S[c][4], S[c][5]); w0.w = pk2(S[c][6], S[c][7]);
            w1.x = pk2(S[c][8], S[c][9]); w1.y = pk2(S[c][10], S[c][11]); w1.z = pk2(S[c][12], S[c][13]); w1.w = pk2(S[c][14], S[c][15]);
            pb[c][0] = __builtin_bit_cast(bf16x8, w0); pb[c][1] = __builtin_bit_cast(bf16x8, w1);
        }
        l = xh_sum(l);
        inv = 1.f / l;
    }
    __syncthreads();
    {
        const bf16_t* vp0 = VXT + (size_t)(b * 1024 + h * 256 + (tid >> 5)) * 256 + (tid & 31) * 8;
        LAS unsigned char* l0 = lds + (tid >> 5) * PITCH + (tid & 31) * 16;
#pragma unroll
        for (int hf = 0; hf < 2; ++hf) { u32x4 vv[8];
#pragma unroll
            for (int i = 0; i < 8; ++i) vv[i] = *(const u32x4*)(vp0 + (size_t)(hf * 8 + i) * 16 * 256);
#pragma unroll
            for (int i = 0; i < 8; ++i) *(LAS u32x4*)(l0 + (hf * 8 + i) * 16 * PITCH) = vv[i];
            asm volatile("" ::: "memory"); }
    }
    __syncthreads();
    bf16_t* op = OX + (size_t)(b * SEQ + q0 + r32) * D + h * 256 + 4 * hi;
#pragma unroll 1
    for (int dt = 0; dt < 8; ++dt) {
        f32x16 o;
#pragma unroll
        for (int r = 0; r < 16; ++r) o[r] = 0.f;
#pragma unroll
        for (int c = 0; c < 8; ++c)
#pragma unroll
            for (int j = 0; j < 2; ++j) { const bf16x8 vf = *(const LAS bf16x8*)(lds + (dt * 32 + r32) * PITCH + (32 * c + 16 * j + 8 * hi) * 2); o = MFMA32(vf, pb[c][j], o); }
#pragma unroll
        for (int g = 0; g < 4; ++g) { u32x2 a; a.x = pk2(o[4 * g] * inv, o[4 * g + 1] * inv); a.y = pk2(o[4 * g + 2] * inv, o[4 * g + 3] * inv); *(u32x2*)(op + dt * 32 + 8 * g) = a; }
    }
    __syncthreads();
}


#define XB_TMO      128
#define XB_XCNT(j)  (256  + 64 * (j))
#define XB_XSUB(j)  (1280 + 64 * (j))
#define XB_XGEN(j)  (2304 + 64 * (j))
#define XB_TOP      3328
#define XB_TOPGEN   3392
#define XCD_BAR_WORDS 3456
#define XB_SPIN_CAP (1u << 22)
DI unsigned xb_ld(unsigned* p)              { return __hip_atomic_load(p, __ATOMIC_RELAXED, __HIP_MEMORY_SCOPE_AGENT); }
DI unsigned xb_add(unsigned* p, unsigned v) { return __hip_atomic_fetch_add(p, v, __ATOMIC_RELAXED, __HIP_MEMORY_SCOPE_AGENT); }
DI unsigned xb_xcc_id() { return (unsigned)__builtin_amdgcn_s_getreg((3 << 11) | 20) & 0xFu; }
#define XB_SPIN(cond, bar) do { unsigned _sp = 0; while (cond) { __builtin_amdgcn_s_sleep(1); \
    if ((++_sp & 255u) == 0u) { if (xb_ld(&(bar)[XB_TMO])) break; if (_sp > XB_SPIN_CAP) { atomicAdd(&(bar)[XB_TMO], 1u); break; } } } } while (0)
DI void xcd_barrier_complete(unsigned* bar, unsigned x, unsigned& nloc, unsigned& nx) {
    const unsigned G = gridDim.x * gridDim.y * gridDim.z;
    unsigned sum, cnt, mine, sp = 0u;
    for (;;) {
        sum = 0u; cnt = 0u; mine = 0u;
#pragma unroll
        for (unsigned j = 0; j < 16; ++j) { const unsigned c = xb_ld(&bar[XB_XCNT(j)]); sum += c; cnt += (c > 0u) ? 1u : 0u; mine = (j == x) ? c : mine; }
        if (sum == G) break;
        __builtin_amdgcn_s_sleep(1);
        if ((++sp & 255u) == 0u) { if (xb_ld(&bar[XB_TMO])) break; if (sp > XB_SPIN_CAP) { atomicAdd(&bar[XB_TMO], 1u); break; } }
    }
    nloc = mine > 0u ? mine : 1u; nx = cnt > 0u ? cnt : 1u;
}
DI void xcd_barrier(unsigned* bar, volatile LAS unsigned* st, int tid) {
    asm volatile("s_waitcnt vmcnt(0)" ::: "memory");
    __syncthreads();
    int tl = threadIdx.x; asm volatile("" : "+v"(tl));
    if (tl == 0) {
        const unsigned x = xb_xcc_id();
        __builtin_amdgcn_s_waitcnt(0);
        unsigned nloc = st[0], nx = st[1];
        if (nloc == 0u) { xcd_barrier_complete(bar, x, nloc, nx); st[0] = nloc; st[1] = nx; }
        const unsigned old = xb_add(&bar[XB_XSUB(x)], 1u);
        const unsigned gen = old / nloc;
        if (old + 1u == (gen + 1u) * nloc) {
            __builtin_amdgcn_fence(__ATOMIC_RELEASE, "agent");
            asm volatile("s_waitcnt vmcnt(0)" ::: "memory");
            const unsigned og = xb_add(&bar[XB_TOP], 1u);
            const unsigned tg = og / nx;
            if (og + 1u == (tg + 1u) * nx) xb_add(&bar[XB_TOPGEN], 1u);
            else XB_SPIN(xb_ld(&bar[XB_TOPGEN]) == tg, bar);
            __builtin_amdgcn_fence(__ATOMIC_ACQUIRE, "agent");
            xb_add(&bar[XB_XGEN(x)], 1u);
            asm volatile("s_waitcnt vmcnt(0)" ::: "memory");
        } else {
            XB_SPIN(xb_ld(&bar[XB_XGEN(x)]) == gen, bar);
            __builtin_amdgcn_fence(__ATOMIC_ACQUIRE, "agent");
            asm volatile("s_waitcnt vmcnt(0)" ::: "memory");
        }
    }
    __syncthreads();
}

constexpr int LDS_BYTES = 147456, BARST_OFF = LDS_BYTES - 64;
constexpr size_t WS_BAR = 65536;
struct Args { const float* in[29]; float* out; unsigned char* ws; int ph_lo, ph_hi; };

typedef const __attribute__((address_space(4))) Args* CArgsP;
DI CArgsP kargs() { CArgsP p = (CArgsP)__builtin_amdgcn_kernarg_segment_ptr(); asm volatile("" : "+s"(p)); return p; }
#define INP(i) (ap->in[i])
#define WSB(off) ((bf16_t*)(ws + (off)))

__global__ void __launch_bounds__(512, 2) fwd_kernel(Args args_unused) {
    extern __shared__ __attribute__((aligned(16))) unsigned char lds_raw[];
    LAS unsigned char* lds = (LAS unsigned char*)lds_raw;
    cg::grid_group grid = cg::this_grid();
    { CArgsP ap0 = kargs();
      volatile LAS unsigned* st0 = (volatile LAS unsigned*)(lds + BARST_OFF);
      if (threadIdx.x == 0) { st0[0] = 0u; st0[1] = 0u; (void)xb_add((unsigned*)(ap0->ws + WS_BAR) + XB_XCNT(xb_xcc_id()), 1u); }
      __syncthreads();
    }
#define PHASE_BEGIN { CArgsP ap = kargs(); unsigned char* ws = ap->ws; float* X = ap->out; (void)X; (void)ws; \
        int G = gridDim.x, bx = blockIdx.x; asm volatile("" : "+s"(G), "+s"(bx)); const int ngw = G * 8; (void)ngw; \
        int tid = threadIdx.x; asm volatile("" : "+v"(tid)); const int lane = tid & 63, wid = __builtin_amdgcn_readfirstlane(tid >> 6), gw = bx * 8 + wid; (void)lane; (void)gw;
#define PHASE_END   xcd_barrier((unsigned*)(ws + WS_BAR), (volatile LAS unsigned*)(lds + BARST_OFF), tid); }

    PHASE_BEGIN
    {
        for (int rep = 0; rep < REP_P0; ++rep) {
        bf16_t* WB = WSB(WS_W);
        LAS float* scr = (LAS float*)(lds + wid * 16384);
        constexpr int I_GU = 16 * 88, I_D = 44 * 32, I_IN = 16 * 160, I_CO = 4 * 32, I_WO = 8 * 32, I_SQ = 16 * 32, I_KV = 16 * 64;
        constexpr int PER_LAYER = 6 * I_GU + I_IN + 2 * I_CO + I_WO + 3 * I_SQ + I_KV;
        static_assert(I_GU == I_D, "item counts");
        for (int it = gw; it < DEPTH * PER_LAYER; it += ngw) {
            const int l = it / PER_LAYER; int r = it % PER_LAYER; bf16_t* wl = WB + (size_t)l * W_LAYER;
            if (r < I_GU) { transpose_item(INP(3) + (size_t)l * D * DFF, D, DFF, wl + WO_1GU, 1, scr, r, lane, INP(2) + l * D); continue; } r -= I_GU;
            if (r < I_GU) { transpose_item(INP(4) + (size_t)l * D * DFF, D, DFF, wl + WO_1GU, 2, scr, r, lane, INP(2) + l * D); continue; } r -= I_GU;
            if (r < I_D) { transpose_item(INP(5) + (size_t)l * D * DFF, DFF, D, wl + WO_1D, 0, scr, r, lane); continue; } r -= I_D;
            if (r < I_IN) { transpose_item(INP(7) + (size_t)l * D * NIN, D, NIN, wl + WO_IN, 3, scr, r, lane, INP(6) + l * D); continue; } r -= I_IN;
            if (r < I_CO) { transpose_item(INP(12) + (size_t)l * 256 * D, 256, D, wl + WO_CO, 0, scr, r, lane, nullptr, D); continue; } r -= I_CO;
            if (r < I_WO) { transpose_item(INP(15) + (size_t)l * 512 * D, 512, D, wl + WO_CO + 256, 0, scr, r, lane, nullptr, D); continue; } r -= I_WO;
            if (r < I_CO) { transpose_item(INP(17) + (size_t)l * 256 * D, 256, D, wl + WO_CO + 768, 0, scr, r, lane, nullptr, D); continue; } r -= I_CO;
            if (r < I_SQ) { transpose_item(INP(18) + (size_t)l * D * D, D, D, wl + WO_OUT, 0, scr, r, lane); continue; } r -= I_SQ;
            if (r < I_SQ) { continue; } r -= I_SQ;
            if (r < I_KV) { transpose_item(INP(22) + (size_t)l * D * 2 * D, D, 2 * D, wl + WO_CKV, 0, scr, r, lane); continue; } r -= I_KV;
            if (r < I_SQ) { transpose_item(INP(23) + (size_t)l * D * D, D, D, wl + WO_COO, 0, scr, r, lane); continue; } r -= I_SQ;
            if (r < I_GU) { transpose_item(INP(25) + (size_t)l * D * DFF, D, DFF, wl + WO_2GU, 1, scr, r, lane, INP(24) + l * D); continue; } r -= I_GU;
            if (r < I_GU) { transpose_item(INP(26) + (size_t)l * D * DFF, D, DFF, wl + WO_2GU, 2, scr, r, lane, INP(24) + l * D); continue; } r -= I_GU;
            transpose_item(INP(27) + (size_t)l * D * DFF, DFF, D, wl + WO_2D, 0, scr, r, lane);
        }
        for (int m = gw; m < DEPTH * D; m += ngw) {
            const int l = m >> 10, k = m & 1023; const float gk = (INP(19) + l * D)[k];
            const f32x4* wr_ = (const f32x4*)(INP(21) + (size_t)l * D * D + (size_t)k * D) + lane; u32x2* o8 = (u32x2*)(WB + (size_t)l * W_LAYER + WO_CQ + (size_t)k * D) + lane;
#pragma unroll
            for (int j = 0; j < 4; ++j) { const f32x4 v = wr_[64 * j] * gk; u32x2 w; w.x = pk2(v.x, v.y); w.y = pk2(v.z, v.w); o8[64 * j] = w; }
        }
        bf16_t* MEMN = WSB(WS_MEMN);
        for (int m = gw; m < DEPTH * BATCH * MEMLEN; m += ngw) { const int l = m / (BATCH * MEMLEN), row = m % (BATCH * MEMLEN);
            rms_row_bf16(INP(1) + (size_t)row * D, INP(20) + l * D, MEMN + (size_t)m * D, lane); }
        {
            const float* xin = INP(0); bf16_t* XB = WSB(WS_XB); u64* SS = (u64*)(ws + WS_SS);
            for (int m0 = gw; m0 < M; m0 += 4 * ngw) {
                f32x4 v[4][4];
#pragma unroll
                for (int q = 0; q < 4; ++q)
#pragma unroll
                    for (int j = 0; j < 4; ++j) v[q][j] = __builtin_nontemporal_load((const f32x4*)(xin + (size_t)(m0 + q * ngw) * D) + lane + 64 * j);
#pragma unroll
                for (int q = 0; q < 4; ++q) { const int m = m0 + q * ngw; u32x2* o8 = (u32x2*)(XB + (size_t)m * D) + lane; float s = 0.f;
#pragma unroll
                    for (int j = 0; j < 4; ++j) { u32x2 w; w.x = pk2(v[q][j].x, v[q][j].y); w.y = pk2(v[q][j].z, v[q][j].w); o8[64 * j] = w;
                        s += (bflo(w.x) * bflo(w.x) + bfhi(w.x) * bfhi(w.x)) + (bflo(w.y) * bflo(w.y) + bfhi(w.y) * bfhi(w.y)); }
                    s = wave_sum(s, lane);
                    if (lane == 0) SS[m] = (u64)(s * SS_SCALE); }
            }
            for (int i = gw * 64 + lane; i < 8 * M; i += ngw * 64) SS[M + i] = 0ull;
        }
        __syncthreads();
        }
    }
    grid.sync(); }

#pragma unroll 1
    for (int l = 0; l < DEPTH; ++l) {
        const size_t wlo = WS_W + (size_t)l * W_LAYER * 2;
#define SSP(k) ((u64*)(ws + WS_SS) + (size_t)(4 * l + (k)) * M)
        PHASE_BEGIN
        {
            pg8::Gemm g{WSB(WS_XB), WSB(wlo) + WO_1GU, D, D, D}; pg8::StaticOrder S; S.init(M, NGU, G, bx);
            EpiSwiGLU E{WSB(WS_U), SSP(0)};
            for (int rep = 0; rep < REP_UP; ++rep) pg8::gemm_phase<EpiSwiGLU, true>(lds, g, S, E);
            if (l == 0) {
#pragma unroll 1
                for (int l2 = 0; l2 < DEPTH; ++l2) {
                    pg8::Gemm g2{WSB(WS_MEMN) + (size_t)l2 * 2048 * D, WSB(WS_W) + (size_t)l2 * W_LAYER + WO_CKV, D, D, D}; pg8::StaticOrder S2; S2.init(2048, 2048, G, (bx + G - 64 * (l2 + 1)) % G);
                    EpiBf16 E2{WSB(WS_KX) + (size_t)l2 * 2048 * 2048, 2048, nullptr};
                    pg8::gemm_phase<EpiBf16, true>(lds, g2, S2, E2);
                }
            }
        }
        PHASE_END
        PHASE_BEGIN
        {
            pg8::Gemm g{WSB(WS_U), WSB(wlo) + WO_1D, DFF, DFF, DFF}; pg8::StaticOrder S; S.init(M, D, G, bx);
            EpiResid E{WSB(WS_XB), SSP(1), 0.5f};
            pg8::gemm_phase<EpiResid, true>(lds, g, S, E);
            if (l == 0) {
                bf16_t* WX = (bf16_t*)X + (size_t)32 * 1024 * 1024;
#pragma unroll 1
                for (int id = bx; id < 512; id += G) {
                    const int kind = id >> 8, rem = id & 255, l2 = rem >> 7, b = (rem >> 4) & 7, hh = (rem >> 2) & 3, q = rem & 3;
                    const bf16_t* KVl = WSB(WS_KX) + (size_t)l2 * 2048 * 2048 + (size_t)(b * 256) * 2048;
                    const bf16_t* wl2 = WSB(WS_W) + (size_t)l2 * W_LAYER;
                    bf16_t* outm = WX + ((size_t)kind * 16 + l2 * 8 + b) * (1024 * 1024);
                    if (kind == 0) {
                        pg8::Gemm g2{KVl + hh * 256, wl2 + WO_CQ + hh * 256, 2048, D, 256}; pg8::StaticOrder S2; S2.init(256, 1024, 4, q);
                        EpiBf16 E2{outm + (size_t)(hh * 256) * 1024, 1024, nullptr};
                        pg8::gemm_phase<EpiBf16, true>(lds, g2, S2, E2);
                    } else {
                        pg8::Gemm g2{wl2 + WO_COO + hh * 256, KVl + 1024 + hh * 256, D, 2048, 256}; pg8::StaticOrder S2; S2.init(1024, 256, 4, q);
                        EpiBf16 E2{outm + hh * 256, 1024, nullptr};
                        pg8::gemm_phase<EpiBf16, true>(lds, g2, S2, E2);
                    }
                }
            }
        }
        PHASE_END
        PHASE_BEGIN
        {
            pg8::Gemm g{WSB(WS_XB), WSB(wlo) + WO_IN, D, D, D}; pg8::StaticOrder S; S.init(M, NIN, G, bx);
            EpiWin E{WSB(WS_U), WSB(WS_VTB), WSB(WS_VTC), WSB(WS_VFB), WSB(WS_VFC), WSB(WS_G), SSP(1)};
            pg8::gemm_phase<EpiWin, true>(lds, g, S, E);
        }
        PHASE_END
        PHASE_BEGIN
        {
            bf16_t* Ub = WSB(WS_U); bf16_t* MIX = (bf16_t*)X;
            LAS float* t5tab = (LAS float*)(lds + 114688);
            LAS float* rpbtab = (LAS float*)(lds + 114688 + 8224);
            { const float* t5 = INP(14); const float* rpb = INP(16) + (size_t)l * 4 * 15 * 31;
            for (int i = tid; i < 8 * 257; i += 512) { const int hh = i / 257, rel = i % 257 - 128, n = rel < 0 ? -rel : rel;
                const int bk = (rel > 0 ? 16 : 0) + (n < 8 ? n : n < 12 ? 8 : n < 16 ? 9 : n < 23 ? 10 : n < 32 ? 11 : n < 46 ? 12 : n < 64 ? 13 : n < 91 ? 14 : 15);
                t5tab[i] = t5[bk * 8 + hh] * LOG2E; }
            for (int i = tid; i < 4 * 15 * 31; i += 512) rpbtab[i] = rpb[i] * LOG2E; }
            __syncthreads();
            for (int rep = 0; rep < REP_MIX; ++rep) {
            const int vbx = (G % 8 == 0) ? (bx & 7) * (G >> 3) + (bx >> 3) : bx;
            for (int cu = vbx; cu < BATCH * 64; cu += G)
                conv_unit(lds, Ub, MIX, INP(8) + (size_t)l * 31 * 256, INP(9) + l * 256, INP(10) + l * 256, INP(11) + l * 256, cu >> 6, cu & 63, tid, wid, lane);
            { const bf16_t* KFB = WSB(WS_VTB); const bf16_t* VFB = WSB(WS_VFB); const float* sink = INP(13) + l * 8;
            for (int u = vbx * 8 + wid; u < BATCH * 128 * 4; u += ngw) { const int hp = u & 3, st = (u >> 2) & 127, b = u >> 9;
                win_pair_unit(Ub, KFB, VFB, MIX, t5tab, b, st, hp, lane, sink[2 * hp] * LOG2E, sink[2 * hp + 1] * LOG2E); } }
            { const bf16_t* KFC = WSB(WS_VTC); const bf16_t* VFC = WSB(WS_VFC);
            int t3 = threadIdx.x; asm volatile("" : "+v"(t3)); const int lane3 = t3 & 63, gw3 = vbx * 8 + __builtin_amdgcn_readfirstlane(t3 >> 6);
            for (int u = gw3; u < BATCH * 64 * 4; u += ngw) { const int hh = u & 3, qr = (u >> 2) & 63, b = u >> 8;
                na_row_unit(Ub, KFC, VFC, MIX, rpbtab, b, qr, hh, lane3); } }
            }
            __syncthreads();
        }
        PHASE_END
        PHASE_BEGIN
        {
            const bf16_t* MIX = (const bf16_t*)X;
            pg8::StaticOrder S; S.init(M, D, G, bx);
            pg8::Gemm g{MIX, WSB(wlo) + WO_CO, D, D, D}; EpiYF E{WSB(WS_Y), WSB(WS_G)};
            for (int rep = 0; rep < REP_Y; ++rep) pg8::gemm_phase<EpiYF, true>(lds, g, S, E);
        }
        PHASE_END
        PHASE_BEGIN
        {
            pg8::Gemm g{WSB(WS_Y), WSB(wlo) + WO_OUT, D, D, D}; pg8::StaticOrder S; S.init(M, D, G, bx);
            EpiResid E{WSB(WS_XB), SSP(2), 1.0f};
            pg8::gemm_phase<EpiResid, true>(lds, g, S, E);
        }
        PHASE_END
        PHASE_BEGIN
        {
            const bf16_t* WX = (const bf16_t*)X + (size_t)32 * 1024 * 1024;
            pg8::Gemm g{WSB(WS_XB), WX + (size_t)(l * 8) * (1024 * 1024), D, D, D, (size_t)1024 * 1024}; pg8::StaticOrder S; S.init(M, D, G, bx);
            EpiSoftmax E{WSB(WS_QX), SSP(2), (LAS float*)(lds + LDS_XCH)};
            pg8::gemm_phase<EpiSoftmax, true>(lds, g, S, E);
        }
        PHASE_END
        PHASE_BEGIN
        {
            const bf16_t* WX = (const bf16_t*)X + (size_t)32 * 1024 * 1024;
            pg8::Gemm g{WSB(WS_QX), WX + (size_t)(16 + l * 8) * (1024 * 1024), D, D, D, (size_t)1024 * 1024}; pg8::StaticOrder S; S.init(M, D, G, bx);
            EpiResid E{WSB(WS_XB), SSP(3), 1.0f};
            pg8::gemm_phase<EpiResid, true>(lds, g, S, E);
        }
        PHASE_END
        PHASE_BEGIN
        {
            pg8::Gemm g{WSB(WS_XB), WSB(wlo) + WO_2GU, D, D, D}; pg8::StaticOrder S; S.init(M, NGU, G, bx);
            EpiSwiGLU E{WSB(WS_U), SSP(3)};
            for (int rep = 0; rep < REP_UP; ++rep) pg8::gemm_phase<EpiSwiGLU, true>(lds, g, S, E);
        }
        PHASE_END
        PHASE_BEGIN
        {
            pg8::Gemm g{WSB(WS_U), WSB(wlo) + WO_2D, DFF, DFF, DFF}; pg8::StaticOrder S; S.init(M, D, G, bx);
            EpiResid E{WSB(WS_XB), SSP(4), 0.5f};
            pg8::gemm_phase<EpiResid, true>(lds, g, S, E);
        }
        PHASE_END
    }
    {
        CArgsP ap = kargs(); unsigned char* ws = ap->ws; float* X = ap->out;
        int G = gridDim.x, bx = blockIdx.x; asm volatile("" : "+s"(G), "+s"(bx));
        int tid = threadIdx.x; asm volatile("" : "+v"(tid)); const int lane = tid & 63, wid = __builtin_amdgcn_readfirstlane(tid >> 6), gw = bx * 8 + wid, ngw = G * 8;
        const float* gf = INP(28); const bf16_t* XB = WSB(WS_XB); const u64* SS = (const u64*)(ws + WS_SS) + (size_t)8 * M;
        f32x4 gg[4];
#pragma unroll
        for (int j = 0; j < 4; ++j) gg[j] = ((const f32x4*)gf + lane)[64 * j];
        for (int m0 = gw; m0 < M; m0 += 4 * ngw) {
            u32x2 w[4][4]; float rs[4];
#pragma unroll
            for (int q = 0; q < 4; ++q) { const int m = m0 + q * ngw; rs[q] = rsqrtf((float)SS[m] * SS_INV + EPS);
#pragma unroll
                for (int j = 0; j < 4; ++j) w[q][j] = __builtin_nontemporal_load((const u32x2*)(XB + (size_t)m * D) + lane + 64 * j); }
#pragma unroll
            for (int q = 0; q < 4; ++q) { f32x4* orow = (f32x4*)(X + (size_t)(m0 + q * ngw) * D) + lane;
#pragma unroll
                for (int j = 0; j < 4; ++j) __builtin_nontemporal_store((f32x4){bflo(w[q][j].x) * rs[q] * gg[j].x, bfhi(w[q][j].x) * rs[q] * gg[j].y, bflo(w[q][j].y) * rs[q] * gg[j].z, bfhi(w[q][j].y) * rs[q] * gg[j].w}, orow + 64 * j); }
        }
    }
}
constexpr int N_PHASES = 1 + DEPTH * 15;

extern "C" void kernel_launch(void* const* d_in, const int* in_sizes, int n_in, void* d_out, int out_size, void* d_ws, size_t ws_size, hipStream_t stream) {
    static int grid = 0;
    if (grid == 0) {
        if (n_in != 29 || out_size != M * D || ws_size < WS_NEED) { fprintf(stderr, "kernel_launch: unexpected problem (n_in %d, out %d, ws %zu)\n", n_in, out_size, ws_size); grid = -1; return; }
        int dev = 0, cus = 0, per_cu = 0;
        hipGetDevice(&dev);
        hipDeviceGetAttribute(&cus, hipDeviceAttributeMultiprocessorCount, dev);
        if (hipFuncSetAttribute((const void*)fwd_kernel, hipFuncAttributeMaxDynamicSharedMemorySize, LDS_BYTES) != hipSuccess) { fprintf(stderr, "kernel_launch: hipFuncSetAttribute failed\n"); grid = -1; return; }
        if (hipOccupancyMaxActiveBlocksPerMultiprocessor(&per_cu, (const void*)fwd_kernel, 512, LDS_BYTES) != hipSuccess || per_cu < 1) { fprintf(stderr, "kernel_launch: occupancy query gave %d\n", per_cu); per_cu = 1; }
        (void)hipGetLastError();
        grid = cus * per_cu;
    }
    if (grid < 0) return;
    if (hipMemsetAsync((char*)d_ws, 0, 262144, stream) != hipSuccess) { fprintf(stderr, "kernel_launch: memset failed\n"); return; }
    Args a{};
    for (int i = 0; i < 29; ++i) a.in[i] = (const float*)d_in[i];
    a.out = (float*)d_out; a.ws = (unsigned char*)d_ws; a.ph_lo = 0; a.ph_hi = N_PHASES;
    void* kargs[] = {&a};
    hipError_t e = hipLaunchCooperativeKernel((const void*)fwd_kernel, dim3(grid), dim3(512), kargs, LDS_BYTES, stream);
    if (e != hipSuccess) fprintf(stderr, "kernel_launch: cooperative launch failed: %s (grid %d)\n", hipGetErrorString(e), grid);
}
```

```cpp
#include <hip/hip_runtime.h>
#include <hip/hip_cooperative_groups.h>
#include <cstdio>
#include <cstdint>
#include <type_traits>
namespace cg = cooperative_groups;

#ifndef REP_Y
#define REP_Y 1
#endif
#ifndef REP_P0
#define REP_P0 1
#endif
#ifndef REP_UP
#define REP_UP 1
#endif
#ifndef REP_MIX
#define REP_MIX 1
#endif
#ifndef REP_CROSS
#define REP_CROSS 1
#endif
#ifndef REP_NORM
#define REP_NORM 1
#endif
#define DI __device__ __forceinline__
#define LAS __attribute__((address_space(3)))
typedef unsigned short bf16_t;
typedef short bf16x8 __attribute__((ext_vector_type(8)));
typedef float f32x4 __attribute__((ext_vector_type(4)));
typedef float f32x16 __attribute__((ext_vector_type(16)));
typedef unsigned u32x4 __attribute__((ext_vector_type(4)));
typedef unsigned u32x2 __attribute__((ext_vector_type(2)));

constexpr int D = 1024, BATCH = 8, SEQ = 4096, M = BATCH * SEQ, DEPTH = 2, MEMLEN = 256, DFF = 2816, NGU = 2 * DFF, NIN = 5120;
constexpr int UP = 1024;
constexpr int UC_Z = 0, UC_BQ = 256, UC_CQ = 768;
constexpr float EPS = 1e-6f, LOG2E = 1.4426950408889634f;

constexpr size_t MiB = 1u << 20;
constexpr size_t WO_1GU = 0, WO_1D = WO_1GU + (size_t)NGU * D, WO_IN = WO_1D + (size_t)D * DFF, WO_CO = WO_IN + (size_t)NIN * D,
                 WO_WO = WO_CO + (size_t)D * 256, WO_NO = WO_WO + (size_t)D * 512, WO_OUT = WO_NO + (size_t)D * 256, WO_CQ = WO_OUT + (size_t)D * D,
                 WO_CKV = WO_CQ + (size_t)D * D, WO_COO = WO_CKV + (size_t)2 * D * D, WO_2GU = WO_COO + (size_t)D * D, WO_2D = WO_2GU + (size_t)NGU * D,
                 W_LAYER = WO_2D + (size_t)D * DFF;
static_assert(W_LAYER * 2 * DEPTH == 110 * MiB, "weights");
constexpr size_t WS_W = 1 * MiB, WS_KX = 111 * MiB, WS_VXT = 119 * MiB, WS_VTB = 127 * MiB, WS_VTC = 135 * MiB, WS_XB = 151 * MiB, WS_U = 215 * MiB,
                 WS_END = WS_U + 280 * MiB;
static_assert(WS_END == 495 * MiB && (size_t)M * UP * 2 <= 64 * MiB, "ws map");
constexpr size_t WS_MEMN = WS_U + 200 * MiB;
constexpr size_t WS_QX = WS_U, WS_OX = WS_U + 64 * MiB;
constexpr size_t WS_VFB = WS_U + 64 * MiB, WS_VFC = WS_U + 72 * MiB;
constexpr size_t WS_Y = WS_U;
constexpr size_t WS_G = WS_U + 88 * MiB;
constexpr size_t WS_SS = 496 * MiB;
constexpr size_t WS_NEED = WS_SS + (size_t)9 * M * 8;
typedef unsigned long long u64;
constexpr float SS_SCALE = 262144.f, SS_INV = 1.f / (262144.f * 1024.f);

DI unsigned pk2(float lo, float hi) {
    typedef float f2 __attribute__((ext_vector_type(2))); typedef __bf16 b2 __attribute__((ext_vector_type(2)));
    f2 v = {lo, hi}; b2 b = __builtin_convertvector(v, b2); return __builtin_bit_cast(unsigned, b);
}
DI float bflo(unsigned w) { return __uint_as_float(w << 16); }
DI float bfhi(unsigned w) { return __uint_as_float(w & 0xffff0000u); }
DI float einv(float x) { return fminf(1.f + __builtin_amdgcn_exp2f(-LOG2E * x), 1.0e30f); }
DI float sigm(float x) { return __builtin_amdgcn_rcpf(1.f + __builtin_amdgcn_exp2f(-LOG2E * x)); }
DI int tslot(int fr) { return ((fr >> 2) & 1) * 8 + (fr >> 3) * 4 + (fr & 3); }

namespace pg8 {
constexpr int BM = 256, BK = 64, HALF = 128, HTB = HALF * BK * 2, STAGE_BYTES = 8 * HTB, NXCD = 8, WGM = 4;
__host__ __device__ __forceinline__ int lds_byte(int r, int c) { const int st = (r >> 4) * 2 + (c >> 5), rr = r & 15, cc = c & 31, ob = rr * 64 + cc * 2; return st * 1024 + (ob ^ (((ob >> 9) & 1) << 5)); }
__host__ __device__ __forceinline__ void stage_rc(int b, int& R, int& C) { const int st = b / 1024, sb = b % 1024, swz = sb ^ (((sb >> 9) & 1) << 5); R = (st >> 1) * 16 + swz / 64; C = (st & 1) * 32 + (swz % 64) / 2; }
__host__ __device__ __forceinline__ int perm32(int rho) { const int n = rho >> 4, i = rho & 15; return 8 * (i >> 2) + 4 * n + (i & 3); }

struct Unit { int pm, pn; };
struct Gemm { const bf16_t* A; const bf16_t* Bt; int lda, ldb, K; size_t bsB = 0; };
struct StaticOrder {
    int nM, nN, nwg, G, c;
    DI void init(int M_, int N_, int G_, int c_) { nM = M_ / BM; nN = N_ / BM; nwg = nM * nN; G = G_; c = c_; }
    DI bool next(int i, Unit& u) const {
        const long L = (long)i * G + c; if (L >= nwg) return false;
        int wgid = (int)L; { const int q = nwg / NXCD, r = nwg % NXCD, xcd = wgid % NXCD, off = wgid / NXCD; wgid = (xcd < r ? xcd * (q + 1) : r * (q + 1) + (xcd - r) * q) + off; }
        const int nig = WGM * nN, gid = wgid / nig, fm = gid * WGM, gsz = (nM - fm) < WGM ? (nM - fm) : WGM;
        u.pm = fm + ((wgid % nig) % gsz); u.pn = (wgid % nig) / gsz; return true;
    }
};

template <class Epi, bool ALIGN_EPI>
DI void gemm_phase(LAS unsigned char* lds, const Gemm g, const StaticOrder& S, const Epi& E) {
    int tid = threadIdx.x; asm volatile("" : "+v"(tid));
    const int wid = __builtin_amdgcn_readfirstlane(tid >> 6), lane = tid & 63, wr = wid >> 2, wc = wid & 3, fr = lane & 15, fq = lane >> 4;
    const int K = g.K, nt = K / BK;
    unsigned voffA[2], voffB[2];
#pragma unroll
    for (int i = 0; i < 2; ++i) { int R, C; stage_rc(tid * 16 + i * 8192, R, C); const int Rb = Epi::PERM ? ((R & ~31) + perm32(R & 31)) : R;
        voffA[i] = (unsigned)(R * g.lda + C) * 2u; voffB[i] = (unsigned)(Rb * g.ldb + C) * 2u; }
    const size_t kstep = (size_t)(BK * 2);
    const size_t hstepA = (size_t)HALF * g.lda * 2, hstepB = (size_t)HALF * g.ldb * 2;
    const size_t tstepA = 2 * hstepA, tstepB = 2 * hstepB;
    const unsigned ldsw = (unsigned)wid * 1024u;
    const int aoff = lds_byte(wr * 64 + fr, fq * 8), boff = lds_byte(wc * 32 + fr, fq * 8);
#define PG8_SA(b, h) (((b) * 2 + (h)) * HTB)
#define PG8_SB(b, h) ((4 + (b) * 2 + (h)) * HTB)
#define PG8_STAGE(bufoff, gbase, voff) do { _Pragma("unroll") for (int _i = 0; _i < 2; ++_i) \
        __builtin_amdgcn_global_load_lds((const unsigned*)((const char*)(gbase) + (voff)[_i]), (LAS unsigned*)(lds + (bufoff) + ldsw + _i * 8192), 16, 0, 0); } while (0)
#define PG8_LDA(dst, b, h) do { _Pragma("unroll") for (int m = 0; m < 4; ++m) _Pragma("unroll") for (int k = 0; k < 2; ++k) dst[m][k] = *(const LAS bf16x8*)(lds + PG8_SA(b, h) + aoff + m * 2048 + k * 1024); } while (0)
#define PG8_LDB(dst, b, h) do { _Pragma("unroll") for (int n = 0; n < 2; ++n) _Pragma("unroll") for (int k = 0; k < 2; ++k) dst[n][k] = *(const LAS bf16x8*)(lds + PG8_SB(b, h) + boff + n * 2048 + k * 1024); } while (0)
#define PG8_MMA(ai, bj, At, Bt) do { __builtin_amdgcn_s_setprio(1); _Pragma("unroll") for (int m = 0; m < 4; ++m) _Pragma("unroll") for (int n = 0; n < 2; ++n) _Pragma("unroll") for (int k = 0; k < 2; ++k) \
        acc[ai][bj][m][n] = __builtin_amdgcn_mfma_f32_16x16x32_bf16(Bt[n][k], At[m][k], acc[ai][bj][m][n], 0, 0, 0); __builtin_amdgcn_s_setprio(0); } while (0)
#define PG8_WAIT_V(n) asm volatile("s_waitcnt vmcnt(" #n ")" ::: "memory")
#define PG8_WAIT_L(n) asm volatile("s_waitcnt lgkmcnt(" #n ")" ::: "memory")
#define PG8_BAR __builtin_amdgcn_s_barrier()
#define PG8_SCHED __builtin_amdgcn_sched_barrier(0)
    Unit cur, nxt; int ui = 0;
    if (!S.next(0, cur)) return;
    f32x4 acc[2][2][4][2];
#pragma unroll
    for (int a = 0; a < 2; ++a)
#pragma unroll
        for (int b = 0; b < 2; ++b)
#pragma unroll
            for (int m = 0; m < 4; ++m)
#pragma unroll
                for (int n = 0; n < 2; ++n) acc[a][b][m][n] = (f32x4){0.f, 0.f, 0.f, 0.f};
    bf16x8 At[4][2], B0[2][2], B1[2][2];
    const char* cA = (const char*)g.A + (size_t)cur.pm * tstepA; const char* cB = (const char*)g.Bt + (size_t)(cur.pm >> 4) * g.bsB * 2 + (size_t)cur.pn * tstepB;
    PG8_STAGE(PG8_SB(0, 0), cB, voffB); PG8_STAGE(PG8_SB(0, 1), cB + hstepB, voffB); PG8_STAGE(PG8_SA(0, 0), cA, voffA); PG8_STAGE(PG8_SA(0, 1), cA + hstepA, voffA);
    if (wr == 1) PG8_BAR;
    PG8_WAIT_V(2); PG8_BAR;
    PG8_STAGE(PG8_SB(1, 0), cB + kstep, voffB); PG8_STAGE(PG8_SA(1, 0), cA + kstep, voffA); PG8_STAGE(PG8_SB(1, 1), cB + hstepB + kstep, voffB);
    PG8_WAIT_V(6); PG8_BAR;
    for (;;) {
        const bool has_next = S.next(ui + 1, nxt);
        const char* nA = has_next ? (const char*)g.A + (size_t)nxt.pm * tstepA : cA; const char* nB = has_next ? (const char*)g.Bt + (size_t)(nxt.pm >> 4) * g.bsB * 2 + (size_t)nxt.pn * tstepB : cB;
        for (int t = 0; t < nt; t += 2) {
            if constexpr (Epi::HOOK) { if (t == 4 || t == 12) { int t2 = threadIdx.x; asm volatile("" : "+v"(t2)); E.hook(acc, cur, t, wr, wc, t2 & 15, (t2 & 63) >> 4); } }
            const bool last = (t == nt - 2);
            const char* a1 = cA + (size_t)(t + 1) * kstep;
            const char* a2 = last ? nA : cA + (size_t)(t + 2) * kstep; const char* b2 = last ? nB : cB + (size_t)(t + 2) * kstep;
            const char* a3 = a2 + kstep; const char* b3 = b2 + kstep;
            PG8_LDB(B0, 0, 0); PG8_LDB(B1, 0, 1); PG8_SCHED; PG8_LDA(At, 0, 0); PG8_STAGE(PG8_SA(1, 1), a1 + hstepA, voffA);
            PG8_WAIT_V(8); PG8_WAIT_L(0); PG8_BAR; PG8_MMA(0, 0, At, B0); PG8_MMA(0, 1, At, B1); PG8_BAR; PG8_SCHED;
            PG8_LDA(At, 0, 1); PG8_STAGE(PG8_SB(0, 0), b2, voffB); PG8_STAGE(PG8_SB(0, 1), b2 + hstepB, voffB); PG8_STAGE(PG8_SA(0, 0), a2, voffA);
            PG8_WAIT_V(8); PG8_WAIT_L(0); PG8_BAR; PG8_MMA(1, 0, At, B0); PG8_MMA(1, 1, At, B1); PG8_BAR; PG8_SCHED;
            PG8_LDB(B0, 1, 0); PG8_LDB(B1, 1, 1); PG8_SCHED; PG8_LDA(At, 1, 0); PG8_STAGE(PG8_SA(0, 1), a2 + hstepA, voffA);
            PG8_WAIT_V(8); PG8_WAIT_L(0); PG8_BAR; PG8_MMA(0, 0, At, B0); PG8_MMA(0, 1, At, B1); PG8_BAR; PG8_SCHED;
            PG8_LDA(At, 1, 1); PG8_STAGE(PG8_SB(1, 0), b3, voffB); PG8_STAGE(PG8_SB(1, 1), b3 + hstepB, voffB); PG8_STAGE(PG8_SA(1, 0), a3, voffA);
            PG8_WAIT_V(8); PG8_WAIT_L(0); PG8_BAR; PG8_MMA(1, 0, At, B0); PG8_MMA(1, 1, At, B1); PG8_BAR; PG8_SCHED;
        }
        if constexpr (ALIGN_EPI) { if (wr == 0) PG8_BAR; }
        { int t2 = threadIdx.x; asm volatile("" : "+v"(t2)); E(acc, cur, wr, wc, t2 & 15, (t2 & 63) >> 4); }
        if (!has_next) break;
#pragma unroll
        for (int a = 0; a < 2; ++a)
#pragma unroll
            for (int b = 0; b < 2; ++b)
#pragma unroll
                for (int m = 0; m < 4; ++m)
#pragma unroll
                    for (int n = 0; n < 2; ++n) acc[a][b][m][n] = (f32x4){0.f, 0.f, 0.f, 0.f};
        cur = nxt; cA = nA; cB = nB; ++ui;
        if constexpr (ALIGN_EPI) { if (wr == 1) PG8_BAR; }
    }
    PG8_WAIT_V(0);
    if constexpr (!ALIGN_EPI) { if (wr == 0) PG8_BAR; }
    PG8_BAR;
#undef PG8_SA
#undef PG8_SB
#undef PG8_STAGE
#undef PG8_LDA
#undef PG8_LDB
#undef PG8_MMA
#undef PG8_WAIT_V
#undef PG8_WAIT_L
#undef PG8_BAR
#undef PG8_SCHED
}
}
using pg8::Unit;
typedef f32x4 Acc[2][2][4][2];
constexpr int LDS_XCH = 131072;

struct EpiSwiGLU { static constexpr bool PERM = true, HOOK = false; bf16_t* O; const u64* ss;
    DI void operator()(const Acc& acc, const Unit& u, int wr, int wc, int fr, int fq) const {
        const int row0 = u.pm * 256 + wr * 64 + fr, col0 = u.pn * 128 + wc * 32 + 8 * fq;
#pragma unroll
        for (int ai = 0; ai < 2; ++ai)
#pragma unroll
            for (int m = 0; m < 4; ++m) {
                const float rs = rsqrtf((float)ss[row0 + ai * 128 + m * 16] * SS_INV + EPS);
                bf16_t* p = O + (size_t)(row0 + ai * 128 + m * 16) * DFF + col0; float v[8];
#pragma unroll
                for (int n = 0; n < 2; ++n)
#pragma unroll
                    for (int i = 0; i < 4; ++i) { const float gt = acc[ai][0][m][n][i] * rs, up = acc[ai][1][m][n][i] * rs; v[n * 4 + i] = gt * sigm(gt) * up; }
                u32x4 w; w.x = pk2(v[0], v[1]); w.y = pk2(v[2], v[3]); w.z = pk2(v[4], v[5]); w.w = pk2(v[6], v[7]); *(u32x4*)p = w; }
    }
};
struct EpiResid { static constexpr bool PERM = true, HOOK = false; bf16_t* XB; u64* ssn; float alpha;
    DI void operator()(const Acc& acc, const Unit& u, int wr, int wc, int fr, int fq) const {
        const int row0 = u.pm * 256 + wr * 64 + fr, col0 = u.pn * 256 + wc * 32 + 8 * fq, lane = fq * 16 + fr;
        bf16_t* base = XB + (size_t)row0 * D + col0;
        u32x4 xo[2][4][2];
#pragma unroll
        for (int ai = 0; ai < 2; ++ai)
#pragma unroll
            for (int m = 0; m < 4; ++m)
#pragma unroll
                for (int bj = 0; bj < 2; ++bj) xo[ai][m][bj] = *(const u32x4*)(base + (size_t)(ai * 128 + m * 16) * D + bj * 128);
#pragma unroll
        for (int ai = 0; ai < 2; ++ai)
#pragma unroll
            for (int m = 0; m < 4; ++m) { const int row = row0 + ai * 128 + m * 16; bf16_t* rp = base + (size_t)(ai * 128 + m * 16) * D; float sq = 0.f;
#pragma unroll
                for (int bj = 0; bj < 2; ++bj) { const u32x4 xv = xo[ai][m][bj];
                    const f32x4 a = acc[ai][bj][m][0], b = acc[ai][bj][m][1];
                    u32x4 w; w.x = pk2(bflo(xv.x) + alpha * a[0], bfhi(xv.x) + alpha * a[1]); w.y = pk2(bflo(xv.y) + alpha * a[2], bfhi(xv.y) + alpha * a[3]);
                    w.z = pk2(bflo(xv.z) + alpha * b[0], bfhi(xv.z) + alpha * b[1]); w.w = pk2(bflo(xv.w) + alpha * b[2], bfhi(xv.w) + alpha * b[3]);
                    *(u32x4*)(rp + bj * 128) = w;
                    sq += bflo(w.x) * bflo(w.x) + bfhi(w.x) * bfhi(w.x) + bflo(w.y) * bflo(w.y) + bfhi(w.y) * bfhi(w.y)
                        + bflo(w.z) * bflo(w.z) + bfhi(w.z) * bfhi(w.z) + bflo(w.w) * bflo(w.w) + bfhi(w.w) * bfhi(w.w); }
                sq += __int_as_float(__builtin_amdgcn_ds_bpermute((lane ^ 16) << 2, __float_as_int(sq)));
                sq += __int_as_float(__builtin_amdgcn_ds_bpermute((lane ^ 32) << 2, __float_as_int(sq)));
                if (fq == 0) atomicAdd(ssn + row, (u64)(unsigned)(sq * SS_SCALE)); }
    }
};
struct EpiBf16 { static constexpr bool PERM = true, HOOK = false; bf16_t* O; int ldc; const u64* ss;
    DI void operator()(const Acc& acc, const Unit& u, int wr, int wc, int fr, int fq) const {
        const int row0 = u.pm * 256 + wr * 64 + fr, col0 = u.pn * 256 + wc * 32 + 8 * fq;
#pragma unroll
        for (int ai = 0; ai < 2; ++ai)
#pragma unroll
            for (int m = 0; m < 4; ++m) { bf16_t* p = O + (size_t)(row0 + ai * 128 + m * 16) * ldc + col0;
                const float rs = ss ? rsqrtf((float)ss[row0 + ai * 128 + m * 16] * SS_INV + EPS) : 1.f;
#pragma unroll
                for (int bj = 0; bj < 2; ++bj) { const f32x4 a = acc[ai][bj][m][0] * rs, b = acc[ai][bj][m][1] * rs;
                    u32x4 w; w.x = pk2(a[0], a[1]); w.y = pk2(a[2], a[3]); w.z = pk2(b[0], b[1]); w.w = pk2(b[2], b[3]); *(u32x4*)(p + bj * 128) = w; } }
    }
};
DI void store_t(bf16_t* vt, size_t rowlen, int dcol0, int pos, const f32x4& a, const f32x4& b) {
#pragma unroll
    for (int i = 0; i < 4; ++i) { vt[(size_t)(dcol0 + i) * rowlen + pos] = (bf16_t)(pk2(a[i], 0.f) & 0xffffu); vt[(size_t)(dcol0 + 4 + i) * rowlen + pos] = (bf16_t)(pk2(b[i], 0.f) & 0xffffu); }
}
struct EpiSoftmax { static constexpr bool PERM = true, HOOK = false; bf16_t* P; const u64* ss; LAS float* xch;
    DI void operator()(Acc& acc, const Unit& u, int wr, int wc, int fr, int fq) const {
        const int rl0 = wr * 64 + fr, col0 = u.pn * 256 + wc * 32 + 8 * fq, lane = fq * 16 + fr;
        LAS float* rmax = xch; LAS float* rsum = xch + 1024;
        const float SCL = 0.0625f * LOG2E;
#pragma unroll
        for (int ai = 0; ai < 2; ++ai)
#pragma unroll
            for (int m = 0; m < 4; ++m) { const int rl = rl0 + ai * 128 + m * 16;
                const float rs = rsqrtf((float)ss[u.pm * 256 + rl] * SS_INV + EPS) * SCL; float mx = -3.0e38f;
#pragma unroll
                for (int bj = 0; bj < 2; ++bj)
#pragma unroll
                    for (int n = 0; n < 2; ++n) { acc[ai][bj][m][n] = acc[ai][bj][m][n] * rs;
                        mx = fmaxf(fmaxf(mx, fmaxf(acc[ai][bj][m][n][0], acc[ai][bj][m][n][1])), fmaxf(acc[ai][bj][m][n][2], acc[ai][bj][m][n][3])); }
                mx = fmaxf(mx, __int_as_float(__builtin_amdgcn_ds_bpermute((lane ^ 16) << 2, __float_as_int(mx))));
                mx = fmaxf(mx, __int_as_float(__builtin_amdgcn_ds_bpermute((lane ^ 32) << 2, __float_as_int(mx))));
                if (fq == 0) rmax[rl * 4 + wc] = mx; }
        asm volatile("s_waitcnt lgkmcnt(0)" ::: "memory"); __builtin_amdgcn_s_barrier(); asm volatile("" ::: "memory");
#pragma unroll
        for (int ai = 0; ai < 2; ++ai)
#pragma unroll
            for (int m = 0; m < 4; ++m) { const int rl = rl0 + ai * 128 + m * 16;
                const f32x4 m4 = *(const LAS f32x4*)(rmax + rl * 4); const float mx = fmaxf(fmaxf(m4[0], m4[1]), fmaxf(m4[2], m4[3])); float sm = 0.f;
#pragma unroll
                for (int bj = 0; bj < 2; ++bj)
#pragma unroll
                    for (int n = 0; n < 2; ++n)
#pragma unroll
                        for (int i = 0; i < 4; ++i) { const float p = __builtin_amdgcn_exp2f(acc[ai][bj][m][n][i] - mx); acc[ai][bj][m][n][i] = p; sm += p; }
                sm += __int_as_float(__builtin_amdgcn_ds_bpermute((lane ^ 16) << 2, __float_as_int(sm)));
                sm += __int_as_float(__builtin_amdgcn_ds_bpermute((lane ^ 32) << 2, __float_as_int(sm)));
                if (fq == 0) rsum[rl * 4 + wc] = sm; }
        asm volatile("s_waitcnt lgkmcnt(0)" ::: "memory"); __builtin_amdgcn_s_barrier(); asm volatile("" ::: "memory");
#pragma unroll
        for (int ai = 0; ai < 2; ++ai)
#pragma unroll
            for (int m = 0; m < 4; ++m) { const int rl = rl0 + ai * 128 + m * 16;
                const f32x4 s4 = *(const LAS f32x4*)(rsum + rl * 4); const float inv = 1.f / ((s4[0] + s4[1]) + (s4[2] + s4[3]));
                bf16_t* p = P + (size_t)(u.pm * 256 + rl) * D + col0;
#pragma unroll
                for (int bj = 0; bj < 2; ++bj) { const f32x4 a = acc[ai][bj][m][0] * inv, b = acc[ai][bj][m][1] * inv;
                    u32x4 w; w.x = pk2(a[0], a[1]); w.y = pk2(a[2], a[3]); w.z = pk2(b[0], b[1]); w.w = pk2(b[2], b[3]); *(u32x4*)(p + bj * 128) = w; } }
        asm volatile("s_waitcnt lgkmcnt(0)" ::: "memory"); __builtin_amdgcn_s_barrier(); asm volatile("" ::: "memory");
    }
};
struct EpiWin { static constexpr bool PERM = true, HOOK = false; bf16_t* U; bf16_t* KFB; bf16_t* KFC; bf16_t* VFB; bf16_t* VFC; bf16_t* GB; const u64* ss;
    DI void operator()(const Acc& acc_in, const Unit& u, int wr, int wc, int fr, int fq) const {
        const int rl0 = wr * 64 + fr, cl0 = wc * 32 + 8 * fq, pn = u.pn;
        Acc acc;
#pragma unroll
        for (int ai = 0; ai < 2; ++ai)
#pragma unroll
            for (int m = 0; m < 4; ++m) { const float rs = rsqrtf((float)ss[u.pm * 256 + rl0 + ai * 128 + m * 16] * SS_INV + EPS);
#pragma unroll
                for (int bj = 0; bj < 2; ++bj)
#pragma unroll
                    for (int n = 0; n < 2; ++n) acc[ai][bj][m][n] = acc_in[ai][bj][m][n] * rs; }
        const int bb = u.pm >> 4, s0 = (u.pm & 15) * 256;
        if (pn < 2) {
#pragma unroll
            for (int ai = 0; ai < 2; ++ai)
#pragma unroll
                for (int m = 0; m < 4; ++m) { bf16_t* p = U + (size_t)(u.pm * 256 + rl0 + ai * 128 + m * 16) * UP + UC_Z + pn * 128 + cl0; float v[8];
#pragma unroll
                    for (int n = 0; n < 2; ++n)
#pragma unroll
                        for (int i = 0; i < 4; ++i) v[n * 4 + i] = acc[ai][0][m][n][i] * sigm(acc[ai][1][m][n][i]);
                    u32x4 w; w.x = pk2(v[0], v[1]); w.y = pk2(v[2], v[3]); w.z = pk2(v[4], v[5]); w.w = pk2(v[6], v[7]); *(u32x4*)p = w; }
        } else if (pn == 4 || pn == 6 || pn == 7) {
            const int s4k = (wc & 1) * 2 + (fq >> 1), hik = fq & 1;
#pragma unroll
            for (int ai = 0; ai < 2; ++ai)
#pragma unroll
                for (int m = 0; m < 4; ++m) {
                    const int tokb = s0 + ai * 128 + wr * 64 + m * 16, chunk = tokb >> 5, r32k = (tokb & 31) + fr;
                    const int slot = tslot(fr), hiv = slot >> 3, iv = slot & 7, jv = m & 1;
#pragma unroll
                    for (int bj = 0; bj < 2; ++bj) {
                        const f32x4 a = acc[ai][bj][m][0], b = acc[ai][bj][m][1];
                        const bool isK = (pn == 6) || (pn == 4 && bj == 0);
                        if (isK) {
                            const int bh = (pn == 4) ? (bb * 2 + (wc >> 1)) : (bb * 4 + bj * 2 + (wc >> 1));
                            bf16_t* dst = (pn == 4 ? KFB : KFC) + ((size_t)(bh * 128 + chunk) * 4 + s4k) * 512 + (hik * 32 + r32k) * 8;
                            u32x4 w; w.x = pk2(a[0], a[1]); w.y = pk2(a[2], a[3]); w.z = pk2(b[0], b[1]); w.w = pk2(b[2], b[3]); *(u32x4*)dst = w;
                        } else {
                            const int bh = (pn == 4) ? (bb * 2 + (wc >> 1)) : (bb * 4 + bj * 2 + (wc >> 1));
                            const int dtv = wc & 1, dr0 = 8 * fq;
                            bf16_t* dst = (pn == 4 ? VFB : VFC) + (((size_t)(bh * 128 + chunk) * 2 + dtv) * 2 + jv) * 512 + (hiv * 32 + dr0) * 8 + iv;
#pragma unroll
                            for (int i = 0; i < 4; ++i) { dst[i * 8] = (bf16_t)(pk2(a[i], 0.f) & 0xffffu); dst[(4 + i) * 8] = (bf16_t)(pk2(b[i], 0.f) & 0xffffu); }
                        } } }
        } else if (pn >= 8) {
            bf16_t* gp = GB + ((size_t)(((pn - 8) >> 2) * 128 + u.pm) * 4 + ((pn - 8) & 3)) * 65536 + (size_t)(wr * 4 + wc) * 8192 + (fq * 16 + fr) * 8;
#pragma unroll
            for (int ai = 0; ai < 2; ++ai)
#pragma unroll
                for (int m = 0; m < 4; ++m)
#pragma unroll
                    for (int bj = 0; bj < 2; ++bj) { const f32x4 a = acc[ai][bj][m][0], b = acc[ai][bj][m][1];
                        u32x4 w; w.x = pk2(einv(a[0]), einv(a[1])); w.y = pk2(einv(a[2]), einv(a[3])); w.z = pk2(einv(b[0]), einv(b[1])); w.w = pk2(einv(b[2]), einv(b[3]));
                        *(u32x4*)(gp + (ai * 8 + m * 2 + bj) * 512) = w; }
        } else {
            const bool gate = false;
            const int uc = pn == 2 ? UC_BQ : pn == 3 ? UC_BQ + 256 : UC_CQ;
#pragma unroll
            for (int ai = 0; ai < 2; ++ai)
#pragma unroll
                for (int m = 0; m < 4; ++m) { bf16_t* p = U + (size_t)(u.pm * 256 + rl0 + ai * 128 + m * 16) * UP + uc + cl0;
#pragma unroll
                    for (int bj = 0; bj < 2; ++bj) { f32x4 a = acc[ai][bj][m][0], b = acc[ai][bj][m][1];
                        if (gate) {
#pragma unroll
                            for (int i = 0; i < 4; ++i) { a[i] = sigm(a[i]); b[i] = sigm(b[i]); } }
                        u32x4 w; w.x = pk2(a[0], a[1]); w.y = pk2(a[2], a[3]); w.z = pk2(b[0], b[1]); w.w = pk2(b[2], b[3]); *(u32x4*)(p + bj * 128) = w; } }
        }
    }
};
DI void unpack8(const u32x4 w, float (&g)[8]) { g[0] = bflo(w.x); g[1] = bfhi(w.x); g[2] = bflo(w.y); g[3] = bfhi(w.y); g[4] = bflo(w.z); g[5] = bfhi(w.z); g[6] = bflo(w.w); g[7] = bfhi(w.w); }
struct EpiYF { static constexpr bool PERM = true, HOOK = true; bf16_t* Y; const bf16_t* GB;
    DI const bf16_t* gtile(int br, const Unit& u, int wr, int wc, int fr, int fq) const { return GB + ((size_t)(br * 128 + u.pm) * 4 + u.pn) * 65536 + (size_t)(wr * 4 + wc) * 8192 + (fq * 16 + fr) * 8; }
    DI void hook(Acc& acc, const Unit& u, int t, int wr, int wc, int fr, int fq) const {
        const int br = (t == 4) ? 0 : 1;
        const bf16_t* gn = gtile(br, u, wr, wc, fr, fq); const bf16_t* gd = gtile(br + 1, u, wr, wc, fr, fq);
#pragma unroll
        for (int ai = 0; ai < 2; ++ai) {
            u32x4 wn[8], wd[8];
#pragma unroll
            for (int f = 0; f < 8; ++f) { wn[f] = *(const u32x4*)(gn + (ai * 8 + f) * 512); wd[f] = *(const u32x4*)(gd + (ai * 8 + f) * 512); }
#pragma unroll
            for (int m = 0; m < 4; ++m)
#pragma unroll
                for (int bj = 0; bj < 2; ++bj) { float a[8], b[8]; unpack8(wn[m * 2 + bj], a); unpack8(wd[m * 2 + bj], b);
#pragma unroll
                    for (int i = 0; i < 4; ++i) { acc[ai][bj][m][0][i] *= b[i] * __builtin_amdgcn_rcpf(a[i]);
                                                  acc[ai][bj][m][1][i] *= b[4 + i] * __builtin_amdgcn_rcpf(a[4 + i]); } }
            asm volatile("" ::: "memory"); }
    }
    DI void operator()(const Acc& acc, const Unit& u, int wr, int wc, int fr, int fq) const {
        const int row0 = u.pm * 256 + wr * 64 + fr, col0 = u.pn * 256 + wc * 32 + 8 * fq;
        const bf16_t* gc = gtile(2, u, wr, wc, fr, fq);
#pragma unroll
        for (int ai = 0; ai < 2; ++ai) {
            u32x4 wg[8];
#pragma unroll
            for (int f = 0; f < 8; ++f) wg[f] = *(const u32x4*)(gc + (ai * 8 + f) * 512);
#pragma unroll
            for (int m = 0; m < 4; ++m) { bf16_t* rp = Y + (size_t)(row0 + ai * 128 + m * 16) * D + col0;
#pragma unroll
                for (int bj = 0; bj < 2; ++bj) { float g[8]; unpack8(wg[m * 2 + bj], g);
                    const f32x4 a = acc[ai][bj][m][0], b = acc[ai][bj][m][1];
                    u32x4 w; w.x = pk2(a[0] * __builtin_amdgcn_rcpf(g[0]), a[1] * __builtin_amdgcn_rcpf(g[1])); w.y = pk2(a[2] * __builtin_amdgcn_rcpf(g[2]), a[3] * __builtin_amdgcn_rcpf(g[3]));
                    w.z = pk2(b[0] * __builtin_amdgcn_rcpf(g[4]), b[1] * __builtin_amdgcn_rcpf(g[5])); w.w = pk2(b[2] * __builtin_amdgcn_rcpf(g[6]), b[3] * __builtin_amdgcn_rcpf(g[7]));
                    *(u32x4*)(rp + bj * 128) = w; } }
            asm volatile("" ::: "memory"); }
    }
};

DI float shx(float v, int o, int lane) { return __int_as_float(__builtin_amdgcn_ds_bpermute((lane ^ o) << 2, __float_as_int(v))); }
DI float xh_max(float m) { const auto rr = __builtin_amdgcn_permlane32_swap(__float_as_uint(m), __float_as_uint(m), false, false); return fmaxf(__uint_as_float(rr[0]), __uint_as_float(rr[1])); }
DI float xh_sum(float m) { const auto rr = __builtin_amdgcn_permlane32_swap(__float_as_uint(m), __float_as_uint(m), false, false); return __uint_as_float(rr[0]) + __uint_as_float(rr[1]); }
DI float wave_sum(float v, int lane) {
#pragma unroll
    for (int o = 1; o < 64; o <<= 1) v += shx(v, o, lane);
    return v;
}
DI void transpose_item(const float* W, int K, int N, bf16_t* WT, int mode, LAS float* scr, int item, int lane, const float* gain = nullptr, int ldw = 0) {
    if (ldw == 0) ldw = K;
    const int nblk = N / 32, kb = item / nblk, nb = item % nblk, k0 = 64 * kb, n0 = 32 * nb;
    int rowbase = n0;
    if (mode == 1) rowbase = 256 * (n0 >> 7) + (n0 & 127);
    else if (mode == 2) rowbase = 256 * (n0 >> 7) + 128 + (n0 & 127);
    else if (mode == 3) { if (n0 < 256) rowbase = 256 * (n0 >> 7) + (n0 & 127); else if (n0 < 512) { const int j = n0 - 256; rowbase = 256 * (j >> 7) + 128 + (j & 127); } }
    float wv[32];
#pragma unroll
    for (int i = 0; i < 32; ++i) wv[i] = __builtin_nontemporal_load(&W[(size_t)(k0 + 2 * i + (lane >> 5)) * N + n0 + (lane & 31)]);
    if (gain) {
#pragma unroll
        for (int i = 0; i < 32; ++i) wv[i] *= gain[k0 + 2 * i + (lane >> 5)]; }
#pragma unroll
    for (int i = 0; i < 32; ++i) scr[(2 * i + (lane >> 5)) * 33 + (lane & 31)] = wv[i];
    asm volatile("s_waitcnt lgkmcnt(0)" ::: "memory");
    const int c = lane & 7;
#pragma unroll
    for (int j = 0; j < 4; ++j) { const int n = (lane >> 3) + 8 * j; const LAS float* s = scr + (8 * c) * 33 + n;
        u32x4 o; o.x = pk2(s[0 * 33], s[1 * 33]); o.y = pk2(s[2 * 33], s[3 * 33]); o.z = pk2(s[4 * 33], s[5 * 33]); o.w = pk2(s[6 * 33], s[7 * 33]);
        *(u32x4*)(WT + (size_t)(rowbase + n) * ldw + k0 + 8 * c) = o; }
    asm volatile("s_waitcnt lgkmcnt(0)" ::: "memory");
}
DI void rms_row_bf16(const float* xrow, const float* g, bf16_t* orow, int lane) {
    const f32x4* xr = (const f32x4*)xrow + lane; const f32x4* gr = (const f32x4*)g + lane;
    f32x4 v[4]; float s = 0.f;
#pragma unroll
    for (int j = 0; j < 4; ++j) { v[j] = xr[64 * j]; s += (v[j].x * v[j].x + v[j].y * v[j].y) + (v[j].z * v[j].z + v[j].w * v[j].w); }
    const float rstd = 1.f / sqrtf(wave_sum(s, lane) * (1.f / D) + EPS);
    u32x2* o8 = (u32x2*)orow + lane;
#pragma unroll
    for (int j = 0; j < 4; ++j) { const f32x4 gg = gr[64 * j]; u32x2 w; w.x = pk2(v[j].x * rstd * gg.x, v[j].y * rstd * gg.y); w.y = pk2(v[j].z * rstd * gg.z, v[j].w * rstd * gg.w); o8[64 * j] = w; }
}
DI void norm_phase(const float* X, const float* g, bf16_t* XN, int gw, int ngw, int lane) {
    for (int m = gw; m < M; m += ngw) rms_row_bf16(X + (size_t)m * D, g, XN + (size_t)m * D, lane);
}

DI void conv_unit(LAS unsigned char* lds, const bf16_t* U, bf16_t* MIX, const float* dw_w, const float* dw_b, const float* ln_g, const float* ln_b, int b, int tc, int tid, int wid, int lane) {
    LAS bf16_t* zt = (LAS bf16_t*)lds;
    LAS float* cv = (LAS float*)(lds + 49152);
    const int tok0 = tc * 64;
    {
        u32x4 v[6];
#pragma unroll
        for (int i = 0; i < 6; ++i) { const int row = (tid >> 5) + 16 * i, t = tok0 - 15 + row; v[i] = (u32x4){0u, 0u, 0u, 0u};
            if (row < 94 && t >= 0 && t < SEQ) v[i] = *(const u32x4*)(U + (size_t)(b * SEQ + t) * UP + UC_Z + (tid & 31) * 8); }
#pragma unroll
        for (int i = 0; i < 6; ++i) { const int row = (tid >> 5) + 16 * i; if (row < 94) *(LAS u32x4*)(zt + row * 256 + (tid & 31) * 8) = v[i]; }
    }
    __syncthreads();
    {
        const int c = tid & 255, half = tid >> 8;
        float w[31];
#pragma unroll
        for (int j = 0; j < 31; ++j) w[j] = dw_w[j * 256 + c];
        const float bias = dw_b[c];
#pragma unroll 1
        for (int pass = 0; pass < 2; ++pass) {
            const int tl0 = half * 32 + pass * 16;
            float zv[46];
#pragma unroll
            for (int i = 0; i < 46; ++i) zv[i] = __uint_as_float((unsigned)zt[(tl0 + i) * 256 + c] << 16);
#pragma unroll
            for (int t = 0; t < 16; ++t) { float a = bias;
#pragma unroll
                for (int j = 0; j < 31; ++j) a += zv[t + j] * w[j];
                cv[(tl0 + t) * 256 + c] = a; }
        }
    }
    __syncthreads();
    {
        const f32x4 g4 = *(const f32x4*)(ln_g + lane * 4), b4 = *(const f32x4*)(ln_b + lane * 4);
        f32x4 x[8]; float s[8];
#pragma unroll
        for (int i = 0; i < 8; ++i) { x[i] = *(const LAS f32x4*)(cv + (wid + 8 * i) * 256 + lane * 4); s[i] = (x[i].x + x[i].y) + (x[i].z + x[i].w); }
#pragma unroll
        for (int o = 1; o < 64; o <<= 1)
#pragma unroll
            for (int i = 0; i < 8; ++i) s[i] += shx(s[i], o, lane);
#pragma unroll
        for (int i = 0; i < 8; ++i) { x[i] = x[i] - s[i] * (1.f / 256.f); s[i] = (x[i].x * x[i].x + x[i].y * x[i].y) + (x[i].z * x[i].z + x[i].w * x[i].w); }
#pragma unroll
        for (int o = 1; o < 64; o <<= 1)
#pragma unroll
            for (int i = 0; i < 8; ++i) s[i] += shx(s[i], o, lane);
#pragma unroll
        for (int i = 0; i < 8; ++i) { const int tl = wid + 8 * i; const float rstd = 1.f / sqrtf(s[i] * (1.f / 256.f) + EPS);
            f32x4 y = x[i] * rstd * g4 + b4;
            y.x *= sigm(y.x); y.y *= sigm(y.y); y.z *= sigm(y.z); y.w *= sigm(y.w);
            u32x2 o; o.x = pk2(y.x, y.y); o.y = pk2(y.z, y.w);
            *(u32x2*)(MIX + (size_t)(b * SEQ + tok0 + tl) * D + lane * 4) = o; }
    }
    __syncthreads();
}

#define MFMA32(a, b, c) __builtin_amdgcn_mfma_f32_32x32x16_bf16((a), (b), (c), 0, 0, 0)
template <int MODE>
DI void attn_unit(const bf16_t* __restrict__ U, const bf16_t* __restrict__ KF, const bf16_t* __restrict__ VF, bf16_t* __restrict__ MIX, const LAS float* tab, int b, int st, int h, int lane, float sink2) {
    const int r32 = lane & 31, hi = lane >> 5, q0 = st * 32;
    constexpr int QCOL = MODE ? UC_CQ : UC_BQ, OCOL = MODE ? 768 : 256, NKH = MODE ? 4 : 2, NCH = MODE ? 16 : 9;
    const int kh = MODE ? h : (h >> 2);
    const bf16_t* qp = U + (size_t)(b * SEQ + q0 + r32) * UP + QCOL + h * 64 + 8 * hi;
    bf16x8 qf[4];
#pragma unroll
    for (int s = 0; s < 4; ++s) qf[s] = *(const bf16x8*)(qp + 16 * s);
    const bf16_t* kbase = KF + (size_t)(b * NKH + kh) * (SEQ * 64) + lane * 8;
    const bf16_t* vbase = VF + (size_t)(b * NKH + kh) * (SEQ * 64) + lane * 8;
    float mrun = MODE ? -30000.f : sink2, l = 0.f;
    f32x16 o0, o1;
#pragma unroll
    for (int r = 0; r < 16; ++r) { o0[r] = 0.f; o1[r] = 0.f; }
    const float SC = 0.125f * LOG2E;
    const int qrow = q0 >> 6, rs = min(max(qrow - 4, 0), 56);
    const int qc = (q0 & 63) + r32, cs = min(max(qc - 8, 0), 48);
    bf16x8 kf[3][4], vf[3][4];
#define KV0(c) (MODE ? ((rs + ((c) >> 1)) * 64 + ((c) & 1) * 32) : (q0 - 128 + 32 * (c)))
#define LOADKV(slot, c) do { const int kvc_ = min(max(KV0(c), 0), SEQ - 32); const bf16_t* kp_ = kbase + (size_t)(kvc_ >> 5) * 2048; const bf16_t* vp_ = vbase + (size_t)(kvc_ >> 5) * 2048; \
        _Pragma("unroll") for (int s4 = 0; s4 < 4; ++s4) { kf[slot][s4] = *(const bf16x8*)(kp_ + 512 * s4); vf[slot][s4] = *(const bf16x8*)(vp_ + 512 * s4); } } while (0)
    LOADKV(0, 0); LOADKV(1, 1);
    auto chunk = [&](const int c, auto slot_c, auto pslot_c) __attribute__((always_inline)) {
        constexpr int SLOT = decltype(slot_c)::value, PSLOT = decltype(pslot_c)::value;
        if (c + 2 < NCH) LOADKV(PSLOT, c + 2);
        const int kv0 = KV0(c);
        if (c >= NCH || (MODE == 0 && (kv0 < 0 || kv0 >= SEQ))) return;
        f32x16 s;
#pragma unroll
        for (int r = 0; r < 16; ++r) s[r] = 0.f;
#pragma unroll
        for (int s4 = 0; s4 < 4; ++s4) s = MFMA32(kf[SLOT][s4], qf[s4], s);
        float t[16];
        if (MODE == 0) {
            const int base = kv0 - q0 + 4 * hi - r32 + 128;
            if (c == 0 || c == NCH - 1) {
#pragma unroll
                for (int r = 0; r < 16; ++r) { const int idx = base + (r & 3) + 8 * (r >> 2); const bool ok = (unsigned)idx <= 256u;
                    const float bv = tab[h * 257 + (ok ? idx : 0)]; t[r] = ok ? s[r] * SC + bv : -1e30f; }
            } else {
#pragma unroll
                for (int r = 0; r < 16; ++r) t[r] = s[r] * SC + tab[h * 257 + base + (r & 3) + 8 * (r >> 2)];
            }
        } else {
            const int kcb = (kv0 & 63) + 4 * hi, drow = (kv0 >> 6) - qrow;
            const LAS float* tp = tab + (h * 15 + drow + 7) * 31 + 15 - qc + kcb;
            const int rel0 = kcb - cs;
#pragma unroll
            for (int r = 0; r < 16; ++r) { const bool ok = (unsigned)(rel0 + (r & 3) + 8 * (r >> 2)) < 16u;
                const float bv = tp[(r & 3) + 8 * (r >> 2)]; t[r] = ok ? s[r] * SC + bv : -1e30f; }
        }
        float mx = t[0];
#pragma unroll
        for (int r = 1; r < 16; ++r) mx = fmaxf(mx, t[r]);
        mx = xh_max(mx);
        const float mnew = fmaxf(mrun, mx), alpha = __builtin_amdgcn_exp2f(mrun - mnew);
        mrun = mnew;
        float ps = 0.f;
#pragma unroll
        for (int r = 0; r < 16; ++r) { t[r] = __builtin_amdgcn_exp2f(t[r] - mnew); ps += t[r]; }
        l = l * alpha + ps;
#pragma unroll
        for (int r = 0; r < 16; ++r) { o0[r] *= alpha; o1[r] *= alpha; }
        u32x4 w0, w1;
        w0.x = pk2(t[0], t[1]); w0.y = pk2(t[2], t[3]); w0.z = pk2(t[4], t[5]); w0.w = pk2(t[6], t[7]);
        w1.x = pk2(t[8], t[9]); w1.y = pk2(t[10], t[11]); w1.z = pk2(t[12], t[13]); w1.w = pk2(t[14], t[15]);
        const bf16x8 pb0 = __builtin_bit_cast(bf16x8, w0), pb1 = __builtin_bit_cast(bf16x8, w1);
        o0 = MFMA32(vf[SLOT][0], pb0, o0); o0 = MFMA32(vf[SLOT][1], pb1, o0);
        o1 = MFMA32(vf[SLOT][2], pb0, o1); o1 = MFMA32(vf[SLOT][3], pb1, o1);
        };
#pragma unroll 1
    for (int c3 = 0; c3 < NCH; c3 += 3) {
        chunk(c3, std::integral_constant<int, 0>{}, std::integral_constant<int, 2>{});
        chunk(c3 + 1, std::integral_constant<int, 1>{}, std::integral_constant<int, 0>{});
        chunk(c3 + 2, std::integral_constant<int, 2>{}, std::integral_constant<int, 1>{});
    }
#undef KV0
#undef LOADKV
    l = xh_sum(l);
    const float den = l + (MODE ? 0.f : __builtin_amdgcn_exp2f(sink2 - mrun));
    const float inv = 1.f / den;
    bf16_t* op = MIX + (size_t)(b * SEQ + q0 + r32) * D + OCOL + h * 64 + 4 * hi;
#pragma unroll
    for (int g = 0; g < 4; ++g) {
        u32x2 a; a.x = pk2(o0[4 * g] * inv, o0[4 * g + 1] * inv); a.y = pk2(o0[4 * g + 2] * inv, o0[4 * g + 3] * inv); *(u32x2*)(op + 8 * g) = a;
        u32x2 c; c.x = pk2(o1[4 * g] * inv, o1[4 * g + 1] * inv); c.y = pk2(o1[4 * g + 2] * inv, o1[4 * g + 3] * inv); *(u32x2*)(op + 32 + 8 * g) = c; }
}

DI void na_row_unit(const bf16_t* __restrict__ U, const bf16_t* __restrict__ KF, const bf16_t* __restrict__ VF, bf16_t* __restrict__ MIX, const LAS float* tab, int b, int qrow, int h, int lane) {
    const int r32 = lane & 31, hi = lane >> 5;
    const bf16_t* qp = U + (size_t)(b * SEQ + qrow * 64 + r32) * UP + UC_CQ + h * 64 + 8 * hi;
    bf16x8 qf[2][4];
#pragma unroll
    for (int sb = 0; sb < 2; ++sb)
#pragma unroll
        for (int s = 0; s < 4; ++s) qf[sb][s] = *(const bf16x8*)(qp + (size_t)sb * 32 * UP + 16 * s);
    const bf16_t* kbase = KF + (size_t)(b * 4 + h) * (SEQ * 64) + lane * 8;
    const bf16_t* vbase = VF + (size_t)(b * 4 + h) * (SEQ * 64) + lane * 8;
    float mrun[2] = {-30000.f, -30000.f}, l[2] = {0.f, 0.f};
    f32x16 o[2][2];
#pragma unroll
    for (int sb = 0; sb < 2; ++sb)
#pragma unroll
        for (int r = 0; r < 16; ++r) { o[sb][0][r] = 0.f; o[sb][1][r] = 0.f; }
    const float SC = 0.125f * LOG2E;
    const int rs = min(max(qrow - 4, 0), 56);
    bf16x8 kf[2][4], vf[2][4];
#define NLOAD(slot, c) do { const bf16_t* kp_ = kbase + (size_t)((rs + ((c) >> 1)) * 2 + ((c) & 1)) * 2048; const bf16_t* vp_ = vbase + (size_t)((rs + ((c) >> 1)) * 2 + ((c) & 1)) * 2048; \
        _Pragma("unroll") for (int s4 = 0; s4 < 4; ++s4) { kf[slot][s4] = *(const bf16x8*)(kp_ + 512 * s4); vf[slot][s4] = *(const bf16x8*)(vp_ + 512 * s4); } } while (0)
    NLOAD(0, 0);
    auto chunk = [&](const int c, auto slot_c) __attribute__((always_inline)) {
        constexpr int SLOT = decltype(slot_c)::value;
        __builtin_amdgcn_iglp_opt(0);
        if (c + 1 < 16) NLOAD(SLOT ^ 1, c + 1);
        const int kcb = (c & 1) * 32 + 4 * hi, drow = rs + (c >> 1) - qrow;
#pragma unroll
        for (int sb = 0; sb < 2; ++sb) {
            const int qc = sb * 32 + r32, cs = min(max(qc - 8, 0), 48);
            f32x16 s;
#pragma unroll
            for (int r = 0; r < 16; ++r) s[r] = 0.f;
#pragma unroll
            for (int s4 = 0; s4 < 4; ++s4) s = MFMA32(kf[SLOT][s4], qf[sb][s4], s);
            if (SLOT != sb) {
                const LAS float* tp = tab + (h * 15 + drow + 7) * 31 + 15 - qc + kcb;
                const int rel0 = kcb - cs, R0 = sb ? 12 : 0;
                float t4[4];
#pragma unroll
                for (int i = 0; i < 4; ++i) { const int r = R0 + i; const bool ok = (unsigned)(rel0 + (r & 3) + 8 * (r >> 2)) < 16u;
                    const float bv = tp[(r & 3) + 8 * (r >> 2)]; t4[i] = ok ? s[r] * SC + bv : -1e30f; }
                float mx = fmaxf(fmaxf(t4[0], t4[1]), fmaxf(t4[2], t4[3]));
                mx = xh_max(mx);
                if (__builtin_amdgcn_ballot_w64(mx > mrun[sb] + 8.f) != 0ull) {
                    const float mnew = fmaxf(mrun[sb], mx), alpha = __builtin_amdgcn_exp2f(mrun[sb] - mnew);
                    mrun[sb] = mnew; l[sb] *= alpha;
#pragma unroll
                    for (int r = 0; r < 16; ++r) { o[sb][0][r] *= alpha; o[sb][1][r] *= alpha; } }
                const float mref = mrun[sb];
                float ps = 0.f;
#pragma unroll
                for (int i = 0; i < 4; ++i) { t4[i] = __builtin_amdgcn_exp2f(t4[i] - mref); ps += t4[i]; }
                l[sb] += ps;
                u32x4 w; w.x = 0u; w.y = 0u; w.z = 0u; w.w = 0u;
                if (sb == 0) { w.x = pk2(t4[0], t4[1]); w.y = pk2(t4[2], t4[3]); } else { w.z = pk2(t4[0], t4[1]); w.w = pk2(t4[2], t4[3]); }
                const bf16x8 pb = __builtin_bit_cast(bf16x8, w);
                o[sb][0] = MFMA32(vf[SLOT][sb], pb, o[sb][0]);
                o[sb][1] = MFMA32(vf[SLOT][2 + sb], pb, o[sb][1]);
            } else {
                const LAS float* tp = tab + (h * 15 + drow + 7) * 31 + 15 - qc + kcb;
                const int rel0 = kcb - cs;
                float t[16];
#pragma unroll
                for (int r = 0; r < 16; ++r) { const bool ok = (unsigned)(rel0 + (r & 3) + 8 * (r >> 2)) < 16u;
                    const float bv = tp[(r & 3) + 8 * (r >> 2)]; t[r] = ok ? s[r] * SC + bv : -1e30f; }
                float mx = t[0];
#pragma unroll
                for (int r = 1; r < 16; ++r) mx = fmaxf(mx, t[r]);
                mx = xh_max(mx);
                if (__builtin_amdgcn_ballot_w64(mx > mrun[sb] + 8.f) != 0ull) {
                    const float mnew = fmaxf(mrun[sb], mx), alpha = __builtin_amdgcn_exp2f(mrun[sb] - mnew);
                    mrun[sb] = mnew; l[sb] *= alpha;
#pragma unroll
                    for (int r = 0; r < 16; ++r) { o[sb][0][r] *= alpha; o[sb][1][r] *= alpha; } }
                const float mref = mrun[sb];
                float ps = 0.f;
#pragma unroll
                for (int r = 0; r < 16; ++r) { t[r] = __builtin_amdgcn_exp2f(t[r] - mref); ps += t[r]; }
                l[sb] += ps;
                u32x4 w0, w1;
                w0.x = pk2(t[0], t[1]); w0.y = pk2(t[2], t[3]); w0.z = pk2(t[4], t[5]); w0.w = pk2(t[6], t[7]);
                w1.x = pk2(t[8], t[9]); w1.y = pk2(t[10], t[11]); w1.z = pk2(t[12], t[13]); w1.w = pk2(t[14], t[15]);
                const bf16x8 pb0 = __builtin_bit_cast(bf16x8, w0), pb1 = __builtin_bit_cast(bf16x8, w1);
                o[sb][0] = MFMA32(vf[SLOT][0], pb0, o[sb][0]); o[sb][0] = MFMA32(vf[SLOT][1], pb1, o[sb][0]);
                o[sb][1] = MFMA32(vf[SLOT][2], pb0, o[sb][1]); o[sb][1] = MFMA32(vf[SLOT][3], pb1, o[sb][1]);
            }
        }
    };
#pragma unroll 1
    for (int c2 = 0; c2 < 16; c2 += 2) {
        chunk(c2, std::integral_constant<int, 0>{});
        chunk(c2 + 1, std::integral_constant<int, 1>{});
    }
#undef NLOAD
#pragma unroll
    for (int sb = 0; sb < 2; ++sb) {
        float lt = xh_sum(l[sb]);
        const float inv = 1.f / lt;
        bf16_t* op = MIX + (size_t)(b * SEQ + qrow * 64 + sb * 32 + r32) * D + 768 + h * 64 + 4 * hi;
#pragma unroll
        for (int g = 0; g < 4; ++g) {
            u32x2 a; a.x = pk2(o[sb][0][4 * g] * inv, o[sb][0][4 * g + 1] * inv); a.y = pk2(o[sb][0][4 * g + 2] * inv, o[sb][0][4 * g + 3] * inv); *(u32x2*)(op + 8 * g) = a;
            u32x2 c; c.x = pk2(o[sb][1][4 * g] * inv, o[sb][1][4 * g + 1] * inv); c.y = pk2(o[sb][1][4 * g + 2] * inv, o[sb][1][4 * g + 3] * inv); *(u32x2*)(op + 32 + 8 * g) = c; }
    }
}

DI void win_pair_unit(const bf16_t* __restrict__ U, const bf16_t* __restrict__ KF, const bf16_t* __restrict__ VF, bf16_t* __restrict__ MIX, const LAS float* tab, int b, int st, int hp, int lane, float sinkA, float sinkB) {
    const int r32 = lane & 31, hi = lane >> 5, q0 = st * 32, h0 = hp * 2, kh = hp >> 1;
    const bf16_t* qp = U + (size_t)(b * SEQ + q0 + r32) * UP + UC_BQ + h0 * 64 + 8 * hi;
    bf16x8 qf[2][4];
#pragma unroll
    for (int hh = 0; hh < 2; ++hh)
#pragma unroll
        for (int s = 0; s < 4; ++s) qf[hh][s] = *(const bf16x8*)(qp + hh * 64 + 16 * s);
    const bf16_t* kbase = KF + (size_t)(b * 2 + kh) * (SEQ * 64) + lane * 8;
    const bf16_t* vbase = VF + (size_t)(b * 2 + kh) * (SEQ * 64) + lane * 8;
    float mrun[2] = {sinkA, sinkB}, l[2] = {0.f, 0.f};
    f32x16 o[2][2];
#pragma unroll
    for (int hh = 0; hh < 2; ++hh)
#pragma unroll
        for (int r = 0; r < 16; ++r) { o[hh][0][r] = 0.f; o[hh][1][r] = 0.f; }
    const float SC = 0.125f * LOG2E;
    bf16x8 kf[2][4], vf[2][4];
#define WLOAD(slot, c) do { const int kvc_ = min(max(q0 - 128 + 32 * (c), 0), SEQ - 32); const bf16_t* kp_ = kbase + (size_t)(kvc_ >> 5) * 2048; const bf16_t* vp_ = vbase + (size_t)(kvc_ >> 5) * 2048; \
        _Pragma("unroll") for (int s4 = 0; s4 < 4; ++s4) { kf[slot][s4] = *(const bf16x8*)(kp_ + 512 * s4); vf[slot][s4] = *(const bf16x8*)(vp_ + 512 * s4); } } while (0)
    WLOAD(0, 0);
    auto chunk = [&](const int c, auto slot_c) __attribute__((always_inline)) {
        constexpr int SLOT = decltype(slot_c)::value;
        __builtin_amdgcn_iglp_opt(0);
        if (c + 1 < 9) WLOAD(SLOT ^ 1, c + 1);
        const int kv0 = q0 - 128 + 32 * c;
        if (c >= 9 || kv0 < 0 || kv0 >= SEQ) return;
        const int base = kv0 - q0 + 4 * hi - r32 + 128;
#pragma unroll
        for (int hh = 0; hh < 2; ++hh) {
            f32x16 s;
#pragma unroll
            for (int r = 0; r < 16; ++r) s[r] = 0.f;
#pragma unroll
            for (int s4 = 0; s4 < 4; ++s4) s = MFMA32(kf[SLOT][s4], qf[hh][s4], s);
            const LAS float* tp = tab + (h0 + hh) * 257;
            float t[16];
            if (c == 0 || c == 8) {
#pragma unroll
                for (int r = 0; r < 16; ++r) { const int idx = base + (r & 3) + 8 * (r >> 2); const bool ok = (unsigned)idx <= 256u;
                    const float bv = tp[ok ? idx : 0]; t[r] = ok ? s[r] * SC + bv : -1e30f; }
            } else {
#pragma unroll
                for (int r = 0; r < 16; ++r) t[r] = s[r] * SC + tp[base + (r & 3) + 8 * (r >> 2)];
            }
            float mx = t[0];
#pragma unroll
            for (int r = 1; r < 16; ++r) mx = fmaxf(mx, t[r]);
            mx = xh_max(mx);
            if (__builtin_amdgcn_ballot_w64(mx > mrun[hh] + 8.f) != 0ull) {
                const float mnew = fmaxf(mrun[hh], mx), alpha = __builtin_amdgcn_exp2f(mrun[hh] - mnew);
                mrun[hh] = mnew; l[hh] *= alpha;
#pragma unroll
                for (int r = 0; r < 16; ++r) { o[hh][0][r] *= alpha; o[hh][1][r] *= alpha; } }
            const float mref = mrun[hh];
            float ps = 0.f;
#pragma unroll
            for (int r = 0; r < 16; ++r) { t[r] = __builtin_amdgcn_exp2f(t[r] - mref); ps += t[r]; }
            l[hh] += ps;
            u32x4 w0, w1;
            w0.x = pk2(t[0], t[1]); w0.y = pk2(t[2], t[3]); w0.z = pk2(t[4], t[5]); w0.w = pk2(t[6], t[7]);
            w1.x = pk2(t[8], t[9]); w1.y = pk2(t[10], t[11]); w1.z = pk2(t[12], t[13]); w1.w = pk2(t[14], t[15]);
            const bf16x8 pb0 = __builtin_bit_cast(bf16x8, w0), pb1 = __builtin_bit_cast(bf16x8, w1);
            o[hh][0] = MFMA32(vf[SLOT][0], pb0, o[hh][0]); o[hh][0] = MFMA32(vf[SLOT][1], pb1, o[hh][0]);
            o[hh][1] = MFMA32(vf[SLOT][2], pb0, o[hh][1]); o[hh][1] = MFMA32(vf[SLOT][3], pb1, o[hh][1]);
        }
    };
#pragma unroll 1
    for (int c2 = 0; c2 < 9; c2 += 2) {
        chunk(c2, std::integral_constant<int, 0>{});
        chunk(c2 + 1, std::integral_constant<int, 1>{});
    }
#undef WLOAD
#pragma unroll
    for (int hh = 0; hh < 2; ++hh) {
        float lt = xh_sum(l[hh]);
        const float inv = 1.f / (lt + __builtin_amdgcn_exp2f((hh ? sinkB : sinkA) - mrun[hh]));
        bf16_t* op = MIX + (size_t)(b * SEQ + q0 + r32) * D + 256 + (h0 + hh) * 64 + 4 * hi;
#pragma unroll
        for (int g = 0; g < 4; ++g) {
            u32x2 a; a.x = pk2(o[hh][0][4 * g] * inv, o[hh][0][4 * g + 1] * inv); a.y = pk2(o[hh][0][4 * g + 2] * inv, o[hh][0][4 * g + 3] * inv); *(u32x2*)(op + 8 * g) = a;
            u32x2 c; c.x = pk2(o[hh][1][4 * g] * inv, o[hh][1][4 * g + 1] * inv); c.y = pk2(o[hh][1][4 * g + 2] * inv, o[hh][1][4 * g + 3] * inv); *(u32x2*)(op + 32 + 8 * g) = c; }
    }
}

DI void cross_unit(LAS unsigned char* lds, const bf16_t* QX, const bf16_t* KX, const bf16_t* VXT, bf16_t* OX, int b, int h, int qb, int tid, int wid, int lane) {
    constexpr int PITCH = 528;
    const int r32 = lane & 31, hi = lane >> 5;
    const int q0 = qb * 256 + wid * 32;
    bf16x8 qf[16];
    {
        const bf16_t* qp = QX + (size_t)(b * SEQ + q0 + r32) * D + h * 256 + 8 * hi;
#pragma unroll
        for (int s = 0; s < 16; ++s) qf[s] = *(const bf16x8*)(qp + 16 * s);
        const bf16_t* kp0 = KX + (size_t)(b * 256 + (tid >> 5)) * D + h * 256 + (tid & 31) * 8;
        LAS unsigned char* l0 = lds + (tid >> 5) * PITCH + (tid & 31) * 16;
#pragma unroll
        for (int hf = 0; hf < 2; ++hf) { u32x4 kv[8];
#pragma unroll
            for (int i = 0; i < 8; ++i) kv[i] = *(const u32x4*)(kp0 + (size_t)(hf * 8 + i) * 16 * D);
#pragma unroll
            for (int i = 0; i < 8; ++i) *(LAS u32x4*)(l0 + (hf * 8 + i) * 16 * PITCH) = kv[i];
            asm volatile("" ::: "memory"); }
    }
    __syncthreads();
    bf16x8 pb[8][2]; float inv;
    {
        f32x16 S[8];
#pragma unroll
        for (int c = 0; c < 8; ++c) {
#pragma unroll
            for (int r = 0; r < 16; ++r) S[c][r] = 0.f;
#pragma unroll
            for (int s = 0; s < 16; ++s) { const bf16x8 kf = *(const LAS bf16x8*)(lds + (32 * c + r32) * PITCH + (16 * s + 8 * hi) * 2); S[c] = MFMA32(kf, qf[s], S[c]); }
        }
        float mx = S[0][0];
#pragma unroll
        for (int c = 0; c < 8; ++c)
#pragma unroll
            for (int r = 0; r < 16; ++r) mx = fmaxf(mx, S[c][r]);
        mx = xh_max(mx);
        const float SC = 0.0625f * LOG2E; float l = 0.f;
#pragma unroll
        for (int c = 0; c < 8; ++c) {
#pragma unroll
            for (int r = 0; r < 16; ++r) { const float p = __builtin_amdgcn_exp2f((S[c][r] - mx) * SC); S[c][r] = p; l += p; }
            u32x4 w0, w1;
            w0.x = pk2(S[c][0], S[c][1]); w0.y = pk2(S[c][2], S[c][3]); w0.z = pk2(S[c][4], S[c][5]); w0.w = pk2(S[c][6], S[c][7]);
            w1.x = pk2(S[c][8], S[c][9]); w1.y = pk2(S[c][10], S[c][11]); w1.z = pk2(S[c][12], S[c][13]); w1.w = pk2(S[c][14], S[c][15]);
            pb[c][0] = __builtin_bit_cast(bf16x8, w0); pb[c][1] = __builtin_bit_cast(bf16x8, w1);
        }
        l = xh_sum(l);
        inv = 1.f / l;
    }
    __syncthreads();
    {
        const bf16_t* vp0 = VXT + (size_t)(b * 1024 + h * 256 + (tid >> 5)) * 256 + (tid & 31) * 8;
        LAS unsigned char* l0 = lds + (tid >> 5) * PITCH + (tid & 31) * 16;
#pragma unroll
        for (int hf = 0; hf < 2; ++hf) { u32x4 vv[8];
#pragma unroll
            for (int i = 0; i < 8; ++i) vv[i] = *(const u32x4*)(vp0 + (size_t)(hf * 8 + i) * 16 * 256);
#pragma unroll
            for (int i = 0; i < 8; ++i) *(LAS u32x4*)(l0 + (hf * 8 + i) * 16 * PITCH) = vv[i];
            asm volatile("" ::: "memory"); }
    }
    __syncthreads();
    bf16_t* op = OX + (size_t)(b * SEQ + q0 + r32) * D + h * 256 + 4 * hi;
#pragma unroll 1
    for (int dt = 0; dt < 8; ++dt) {
        f32x16 o;
#pragma unroll
        for (int r = 0; r < 16; ++r) o[r] = 0.f;
#pragma unroll
        for (int c = 0; c < 8; ++c)
#pragma unroll
            for (int j = 0; j < 2; ++j) { const bf16x8 vf = *(const LAS bf16x8*)(lds + (dt * 32 + r32) * PITCH + (32 * c + 16 * j + 8 * hi) * 2); o = MFMA32(vf, pb[c][j], o); }
#pragma unroll
        for (int g = 0; g < 4; ++g) { u32x2 a; a.x = pk2(o[4 * g] * inv, o[4 * g + 1] * inv); a.y = pk2(o[4 * g + 2] * inv, o[4 * g + 3] * inv); *(u32x2*)(op + dt * 32 + 8 * g) = a; }
    }
    __syncthreads();
}


#define XB_TMO      128
#define XB_XCNT(j)  (256  + 64 * (j))
#define XB_XSUB(j)  (1280 + 64 * (j))
#define XB_XGEN(j)  (2304 + 64 * (j))
#define XB_TOP      3328
#define XB_TOPGEN   3392
#define XCD_BAR_WORDS 3456
#define XB_SPIN_CAP (1u << 22)
DI unsigned xb_ld(unsigned* p)              { return __hip_atomic_load(p, __ATOMIC_RELAXED, __HIP_MEMORY_SCOPE_AGENT); }
DI unsigned xb_add(unsigned* p, unsigned v) { return __hip_atomic_fetch_add(p, v, __ATOMIC_RELAXED, __HIP_MEMORY_SCOPE_AGENT); }
DI unsigned xb_xcc_id() { return (unsigned)__builtin_amdgcn_s_getreg((3 << 11) | 20) & 0xFu; }
#define XB_SPIN(cond, bar) do { unsigned _sp = 0; while (cond) { __builtin_amdgcn_s_sleep(1); \
    if ((++_sp & 255u) == 0u) { if (xb_ld(&(bar)[XB_TMO])) break; if (_sp > XB_SPIN_CAP) { atomicAdd(&(bar)[XB_TMO], 1u); break; } } } } while (0)
DI void xcd_barrier_complete(unsigned* bar, unsigned x, unsigned& nloc, unsigned& nx) {
    const unsigned G = gridDim.x * gridDim.y * gridDim.z;
    unsigned sum, cnt, mine, sp = 0u;
    for (;;) {
        sum = 0u; cnt = 0u; mine = 0u;
#pragma unroll
        for (unsigned j = 0; j < 16; ++j) { const unsigned c = xb_ld(&bar[XB_XCNT(j)]); sum += c; cnt += (c > 0u) ? 1u : 0u; mine = (j == x) ? c : mine; }
        if (sum == G) break;
        __builtin_amdgcn_s_sleep(1);
        if ((++sp & 255u) == 0u) { if (xb_ld(&bar[XB_TMO])) break; if (sp > XB_SPIN_CAP) { atomicAdd(&bar[XB_TMO], 1u); break; } }
    }
    nloc = mine > 0u ? mine : 1u; nx = cnt > 0u ? cnt : 1u;
}
DI void xcd_barrier(unsigned* bar, volatile LAS unsigned* st, int tid) {
    asm volatile("s_waitcnt vmcnt(0)" ::: "memory");
    __syncthreads();
    int tl = threadIdx.x; asm volatile("" : "+v"(tl));
    if (tl == 0) {
        const unsigned x = xb_xcc_id();
        __builtin_amdgcn_s_waitcnt(0);
        unsigned nloc = st[0], nx = st[1];
        if (nloc == 0u) { xcd_barrier_complete(bar, x, nloc, nx); st[0] = nloc; st[1] = nx; }
        const unsigned old = xb_add(&bar[XB_XSUB(x)], 1u);
        const unsigned gen = old / nloc;
        if (old + 1u == (gen + 1u) * nloc) {
            __builtin_amdgcn_fence(__ATOMIC_RELEASE, "agent");
            asm volatile("s_waitcnt vmcnt(0)" ::: "memory");
            const unsigned og = xb_add(&bar[XB_TOP], 1u);
            const unsigned tg = og / nx;
            if (og + 1u == (tg + 1u) * nx) xb_add(&bar[XB_TOPGEN], 1u);
            else XB_SPIN(xb_ld(&bar[XB_TOPGEN]) == tg, bar);
            __builtin_amdgcn_fence(__ATOMIC_ACQUIRE, "agent");
            xb_add(&bar[XB_XGEN(x)], 1u);
            asm volatile("s_waitcnt vmcnt(0)" ::: "memory");
        } else {
            XB_SPIN(xb_ld(&bar[XB_XGEN(x)]) == gen, bar);
            __builtin_amdgcn_fence(__ATOMIC_ACQUIRE, "agent");
            asm volatile("s_waitcnt vmcnt(0)" ::: "memory");
        }
    }
    __syncthreads();
}

constexpr int LDS_BYTES = 147456, BARST_OFF = LDS_BYTES - 64;
constexpr size_t WS_BAR = 65536;
struct Args { const float* in[29]; float* out; unsigned char* ws; int ph_lo, ph_hi; };

typedef const __attribute__((address_space(4))) Args* CArgsP;
DI CArgsP kargs() { CArgsP p = (CArgsP)__builtin_amdgcn_kernarg_segment_ptr(); asm volatile("" : "+s"(p)); return p; }
#define INP(i) (ap->in[i])
#define WSB(off) ((bf16_t*)(ws + (off)))

__global__ void __launch_bounds__(512, 2) fwd_kernel(Args args_unused) {
    extern __shared__ __attribute__((aligned(16))) unsigned char lds_raw[];
    LAS unsigned char* lds = (LAS unsigned char*)lds_raw;
    cg::grid_group grid = cg::this_grid();
    { CArgsP ap0 = kargs();
      volatile LAS unsigned* st0 = (volatile LAS unsigned*)(lds + BARST_OFF);
      if (threadIdx.x == 0) { st0[0] = 0u; st0[1] = 0u; (void)xb_add((unsigned*)(ap0->ws + WS_BAR) + XB_XCNT(xb_xcc_id()), 1u); }
      __syncthreads();
    }
#define PHASE_BEGIN { CArgsP ap = kargs(); unsigned char* ws = ap->ws; float* X = ap->out; (void)X; (void)ws; \
        int G = gridDim.x, bx = blockIdx.x; asm volatile("" : "+s"(G), "+s"(bx)); const int ngw = G * 8; (void)ngw; \
        int tid = threadIdx.x; asm volatile("" : "+v"(tid)); const int lane = tid & 63, wid = __builtin_amdgcn_readfirstlane(tid >> 6), gw = bx * 8 + wid; (void)lane; (void)gw;
#define PHASE_END   xcd_barrier((unsigned*)(ws + WS_BAR), (volatile LAS unsigned*)(lds + BARST_OFF), tid); }

    PHASE_BEGIN
    {
        for (int rep = 0; rep < REP_P0; ++rep) {
        bf16_t* WB = WSB(WS_W);
        LAS float* scr = (LAS float*)(lds + wid * 16384);
        constexpr int I_GU = 16 * 88, I_D = 44 * 32, I_IN = 16 * 160, I_CO = 4 * 32, I_WO = 8 * 32, I_SQ = 16 * 32, I_KV = 16 * 64;
        constexpr int PER_LAYER = 6 * I_GU + I_IN + 2 * I_CO + I_WO + 3 * I_SQ + I_KV;
        static_assert(I_GU == I_D, "item counts");
        for (int it = gw; it < DEPTH * PER_LAYER; it += ngw) {
            const int l = it / PER_LAYER; int r = it % PER_LAYER; bf16_t* wl = WB + (size_t)l * W_LAYER;
            if (r < I_GU) { transpose_item(INP(3) + (size_t)l * D * DFF, D, DFF, wl + WO_1GU, 1, scr, r, lane, INP(2) + l * D); continue; } r -= I_GU;
            if (r < I_GU) { transpose_item(INP(4) + (size_t)l * D * DFF, D, DFF, wl + WO_1GU, 2, scr, r, lane, INP(2) + l * D); continue; } r -= I_GU;
            if (r < I_D) { transpose_item(INP(5) + (size_t)l * D * DFF, DFF, D, wl + WO_1D, 0, scr, r, lane); continue; } r -= I_D;
            if (r < I_IN) { transpose_item(INP(7) + (size_t)l * D * NIN, D, NIN, wl + WO_IN, 3, scr, r, lane, INP(6) + l * D); continue; } r -= I_IN;
            if (r < I_CO) { transpose_item(INP(12) + (size_t)l * 256 * D, 256, D, wl + WO_CO, 0, scr, r, lane, nullptr, D); continue; } r -= I_CO;
            if (r < I_WO) { transpose_item(INP(15) + (size_t)l * 512 * D, 512, D, wl + WO_CO + 256, 0, scr, r, lane, nullptr, D); continue; } r -= I_WO;
            if (r < I_CO) { transpose_item(INP(17) + (size_t)l * 256 * D, 256, D, wl + WO_CO + 768, 0, scr, r, lane, nullptr, D); continue; } r -= I_CO;
            if (r < I_SQ) { transpose_item(INP(18) + (size_t)l * D * D, D, D, wl + WO_OUT, 0, scr, r, lane); continue; } r -= I_SQ;
            if (r < I_SQ) { continue; } r -= I_SQ;
            if (r < I_KV) { transpose_item(INP(22) + (size_t)l * D * 2 * D, D, 2 * D, wl + WO_CKV, 0, scr, r, lane); continue; } r -= I_KV;
            if (r < I_SQ) { transpose_item(INP(23) + (size_t)l * D * D, D, D, wl + WO_COO, 0, scr, r, lane); continue; } r -= I_SQ;
            if (r < I_GU) { transpose_item(INP(25) + (size_t)l * D * DFF, D, DFF, wl + WO_2GU, 1, scr, r, lane, INP(24) + l * D); continue; } r -= I_GU;
            if (r < I_GU) { transpose_item(INP(26) + (size_t)l * D * DFF, D, DFF, wl + WO_2GU, 2, scr, r, lane, INP(24) + l * D); continue; } r -= I_GU;
            transpose_item(INP(27) + (size_t)l * D * DFF, DFF, D, wl + WO_2D, 0, scr, r, lane);
        }
        for (int m = gw; m < DEPTH * D; m += ngw) {
            const int l = m >> 10, k = m & 1023; const float gk = (INP(19) + l * D)[k];
            const f32x4* wr_ = (const f32x4*)(INP(21) + (size_t)l * D * D + (size_t)k * D) + lane; u32x2* o8 = (u32x2*)(WB + (size_t)l * W_LAYER + WO_CQ + (size_t)k * D) + lane;
#pragma unroll
            for (int j = 0; j < 4; ++j) { const f32x4 v = wr_[64 * j] * gk; u32x2 w; w.x = pk2(v.x, v.y); w.y = pk2(v.z, v.w); o8[64 * j] = w; }
        }
        bf16_t* MEMN = WSB(WS_MEMN);
        for (int m = gw; m < DEPTH * BATCH * MEMLEN; m += ngw) { const int l = m / (BATCH * MEMLEN), row = m % (BATCH * MEMLEN);
            rms_row_bf16(INP(1) + (size_t)row * D, INP(20) + l * D, MEMN + (size_t)m * D, lane); }
        {
            const float* xin = INP(0); bf16_t* XB = WSB(WS_XB); u64* SS = (u64*)(ws + WS_SS);
            for (int m0 = gw; m0 < M; m0 += 4 * ngw) {
                f32x4 v[4][4];
#pragma unroll
                for (int q = 0; q < 4; ++q)
#pragma unroll
                    for (int j = 0; j < 4; ++j) v[q][j] = __builtin_nontemporal_load((const f32x4*)(xin + (size_t)(m0 + q * ngw) * D) + lane + 64 * j);
#pragma unroll
                for (int q = 0; q < 4; ++q) { const int m = m0 + q * ngw; u32x2* o8 = (u32x2*)(XB + (size_t)m * D) + lane; float s = 0.f;
#pragma unroll
                    for (int j = 0; j < 4; ++j) { u32x2 w; w.x = pk2(v[q][j].x, v[q][j].y); w.y = pk2(v[q][j].z, v[q][j].w); o8[64 * j] = w;
                        s += (bflo(w.x) * bflo(w.x) + bfhi(w.x) * bfhi(w.x)) + (bflo(w.y) * bflo(w.y) + bfhi(w.y) * bfhi(w.y)); }
                    s = wave_sum(s, lane);
                    if (lane == 0) SS[m] = (u64)(s * SS_SCALE); }
            }
            for (int i = gw * 64 + lane; i < 8 * M; i += ngw * 64) SS[M + i] = 0ull;
        }
        __syncthreads();
        }
    }
    grid.sync(); }

#pragma unroll 1
    for (int l = 0; l < DEPTH; ++l) {
        const size_t wlo = WS_W + (size_t)l * W_LAYER * 2;
#define SSP(k) ((u64*)(ws + WS_SS) + (size_t)(4 * l + (k)) * M)
        PHASE_BEGIN
        {
            pg8::Gemm g{WSB(WS_XB), WSB(wlo) + WO_1GU, D, D, D}; pg8::StaticOrder S; S.init(M, NGU, G, bx);
            EpiSwiGLU E{WSB(WS_U), SSP(0)};
            for (int rep = 0; rep < REP_UP; ++rep) pg8::gemm_phase<EpiSwiGLU, true>(lds, g, S, E);
            if (l == 0) {
#pragma unroll 1
                for (int l2 = 0; l2 < DEPTH; ++l2) {
                    pg8::Gemm g2{WSB(WS_MEMN) + (size_t)l2 * 2048 * D, WSB(WS_W) + (size_t)l2 * W_LAYER + WO_CKV, D, D, D}; pg8::StaticOrder S2; S2.init(2048, 2048, G, (bx + G - 64 * (l2 + 1)) % G);
                    EpiBf16 E2{WSB(WS_KX) + (size_t)l2 * 2048 * 2048, 2048, nullptr};
                    pg8::gemm_phase<EpiBf16, true>(lds, g2, S2, E2);
                }
            }
        }
        PHASE_END
        PHASE_BEGIN
        {
            pg8::Gemm g{WSB(WS_U), WSB(wlo) + WO_1D, DFF, DFF, DFF}; pg8::StaticOrder S; S.init(M, D, G, bx);
            EpiResid E{WSB(WS_XB), SSP(1), 0.5f};
            pg8::gemm_phase<EpiResid, true>(lds, g, S, E);
            if (l == 0) {
                bf16_t* WX = (bf16_t*)X + (size_t)32 * 1024 * 1024;
#pragma unroll 1
                for (int id = bx; id < 512; id += G) {
                    const int kind = id >> 8, rem = id & 255, l2 = rem >> 7, b = (rem >> 4) & 7, hh = (rem >> 2) & 3, q = rem & 3;
                    const bf16_t* KVl = WSB(WS_KX) + (size_t)l2 * 2048 * 2048 + (size_t)(b * 256) * 2048;
                    const bf16_t* wl2 = WSB(WS_W) + (size_t)l2 * W_LAYER;
                    bf16_t* outm = WX + ((size_t)kind * 16 + l2 * 8 + b) * (1024 * 1024);
                    if (kind == 0) {
                        pg8::Gemm g2{KVl + hh * 256, wl2 + WO_CQ + hh * 256, 2048, D, 256}; pg8::StaticOrder S2; S2.init(256, 1024, 4, q);
                        EpiBf16 E2{outm + (size_t)(hh * 256) * 1024, 1024, nullptr};
                        pg8::gemm_phase<EpiBf16, true>(lds, g2, S2, E2);
                    } else {
                        pg8::Gemm g2{wl2 + WO_COO + hh * 256, KVl + 1024 + hh * 256, D, 2048, 256}; pg8::StaticOrder S2; S2.init(1024, 256, 4, q);
                        EpiBf16 E2{outm + hh * 256, 1024, nullptr};
                        pg8::gemm_phase<EpiBf16, true>(lds, g2, S2, E2);
                    }
                }
            }
        }
        PHASE_END
        PHASE_BEGIN
        {
            pg8::Gemm g{WSB(WS_XB), WSB(wlo) + WO_IN, D, D, D}; pg8::StaticOrder S; S.init(M, NIN, G, bx);
            EpiWin E{WSB(WS_U), WSB(WS_VTB), WSB(WS_VTC), WSB(WS_VFB), WSB(WS_VFC), WSB(WS_G), SSP(1)};
            pg8::gemm_phase<EpiWin, true>(lds, g, S, E);
        }
        PHASE_END
        PHASE_BEGIN
        {
            bf16_t* Ub = WSB(WS_U); bf16_t* MIX = (bf16_t*)X;
            LAS float* t5tab = (LAS float*)(lds + 114688);
            LAS float* rpbtab = (LAS float*)(lds + 114688 + 8224);
            { const float* t5 = INP(14); const float* rpb = INP(16) + (size_t)l * 4 * 15 * 31;
            for (int i = tid; i < 8 * 257; i += 512) { const int hh = i / 257, rel = i % 257 - 128, n = rel < 0 ? -rel : rel;
                const int bk = (rel > 0 ? 16 : 0) + (n < 8 ? n : n < 12 ? 8 : n < 16 ? 9 : n < 23 ? 10 : n < 32 ? 11 : n < 46 ? 12 : n < 64 ? 13 : n < 91 ? 14 : 15);
                t5tab[i] = t5[bk * 8 + hh] * LOG2E; }
            for (int i = tid; i < 4 * 15 * 31; i += 512) rpbtab[i] = rpb[i] * LOG2E; }
            __syncthreads();
            for (int rep = 0; rep < REP_MIX; ++rep) {
            const int vbx = (G % 8 == 0) ? (bx & 7) * (G >> 3) + (bx >> 3) : bx;
            for (int cu = vbx; cu < BATCH * 64; cu += G)
                conv_unit(lds, Ub, MIX, INP(8) + (size_t)l * 31 * 256, INP(9) + l * 256, INP(10) + l * 256, INP(11) + l * 256, cu >> 6, cu & 63, tid, wid, lane);
            { const bf16_t* KFB = WSB(WS_VTB); const bf16_t* VFB = WSB(WS_VFB); const float* sink = INP(13) + l * 8;
            for (int u = vbx * 8 + wid; u < BATCH * 128 * 4; u += ngw) { const int hp = u & 3, st = (u >> 2) & 127, b = u >> 9;
                win_pair_unit(Ub, KFB, VFB, MIX, t5tab, b, st, hp, lane, sink[2 * hp] * LOG2E, sink[2 * hp + 1] * LOG2E); } }
            { const bf16_t* KFC = WSB(WS_VTC); const bf16_t* VFC = WSB(WS_VFC);
            int t3 = threadIdx.x; asm volatile("" : "+v"(t3)); const int lane3 = t3 & 63, gw3 = vbx * 8 + __builtin_amdgcn_readfirstlane(t3 >> 6);
            for (int u = gw3; u < BATCH * 64 * 4; u += ngw) { const int hh = u & 3, qr = (u >> 2) & 63, b = u >> 8;
                na_row_unit(Ub, KFC, VFC, MIX, rpbtab, b, qr, hh, lane3); } }
            }
            __syncthreads();
        }
        PHASE_END
        PHASE_BEGIN
        {
            const bf16_t* MIX = (const bf16_t*)X;
            pg8::StaticOrder S; S.init(M, D, G, bx);
            pg8::Gemm g{MIX, WSB(wlo) + WO_CO, D, D, D}; EpiYF E{WSB(WS_Y), WSB(WS_G)};
            for (int rep = 0; rep < REP_Y; ++rep) pg8::gemm_phase<EpiYF, true>(lds, g, S, E);
        }
        PHASE_END
        PHASE_BEGIN
        {
            pg8::Gemm g{WSB(WS_Y), WSB(wlo) + WO_OUT, D, D, D}; pg8::StaticOrder S; S.init(M, D, G, bx);
            EpiResid E{WSB(WS_XB), SSP(2), 1.0f};
            pg8::gemm_phase<EpiResid, true>(lds, g, S, E);
        }
        PHASE_END
        PHASE_BEGIN
        {
            const bf16_t* WX = (const bf16_t*)X + (size_t)32 * 1024 * 1024;
            pg8::Gemm g{WSB(WS_XB), WX + (size_t)(l * 8) * (1024 * 1024), D, D, D, (size_t)1024 * 1024}; pg8::StaticOrder S; S.init(M, D, G, bx);
            EpiSoftmax E{WSB(WS_QX), SSP(2), (LAS float*)(lds + LDS_XCH)};
            pg8::gemm_phase<EpiSoftmax, true>(lds, g, S, E);
        }
        PHASE_END
        PHASE_BEGIN
        {
            const bf16_t* WX = (const bf16_t*)X + (size_t)32 * 1024 * 1024;
            pg8::Gemm g{WSB(WS_QX), WX + (size_t)(16 + l * 8) * (1024 * 1024), D, D, D, (size_t)1024 * 1024}; pg8::StaticOrder S; S.init(M, D, G, bx);
            EpiResid E{WSB(WS_XB), SSP(3), 1.0f};
            pg8::gemm_phase<EpiResid, true>(lds, g, S, E);
        }
        PHASE_END
        PHASE_BEGIN
        {
            pg8::Gemm g{WSB(WS_XB), WSB(wlo) + WO_2GU, D, D, D}; pg8::StaticOrder S; S.init(M, NGU, G, bx);
            EpiSwiGLU E{WSB(WS_U), SSP(3)};
            for (int rep = 0; rep < REP_UP; ++rep) pg8::gemm_phase<EpiSwiGLU, true>(lds, g, S, E);
        }
        PHASE_END
        PHASE_BEGIN
        {
            pg8::Gemm g{WSB(WS_U), WSB(wlo) + WO_2D, DFF, DFF, DFF}; pg8::StaticOrder S; S.init(M, D, G, bx);
            EpiResid E{WSB(WS_XB), SSP(4), 0.5f};
            pg8::gemm_phase<EpiResid, true>(lds, g, S, E);
        }
        PHASE_END
    }
    {
        CArgsP ap = kargs(); unsigned char* ws = ap->ws; float* X = ap->out;
        int G = gridDim.x, bx = blockIdx.x; asm volatile("" : "+s"(G), "+s"(bx));
        int tid = threadIdx.x; asm volatile("" : "+v"(tid)); const int lane = tid & 63, wid = __builtin_amdgcn_readfirstlane(tid >> 6), gw = bx * 8 + wid, ngw = G * 8;
        const float* gf = INP(28); const bf16_t* XB = WSB(WS_XB); const u64* SS = (const u64*)(ws + WS_SS) + (size_t)8 * M;
        f32x4 gg[4];
#pragma unroll
        for (int j = 0; j < 4; ++j) gg[j] = ((const f32x4*)gf + lane)[64 * j];
        for (int m0 = gw; m0 < M; m0 += 4 * ngw) {
            u32x2 w[4][4]; float rs[4];
#pragma unroll
            for (int q = 0; q < 4; ++q) { const int m = m0 + q * ngw; rs[q] = rsqrtf((float)SS[m] * SS_INV + EPS);
#pragma unroll
                for (int j = 0; j < 4; ++j) w[q][j] = __builtin_nontemporal_load((const u32x2*)(XB + (size_t)m * D) + lane + 64 * j); }
#pragma unroll
            for (int q = 0; q < 4; ++q) { f32x4* orow = (f32x4*)(X + (size_t)(m0 + q * ngw) * D) + lane;
#pragma unroll
                for (int j = 0; j < 4; ++j) __builtin_nontemporal_store((f32x4){bflo(w[q][j].x) * rs[q] * gg[j].x, bfhi(w[q][j].x) * rs[q] * gg[j].y, bflo(w[q][j].y) * rs[q] * gg[j].z, bfhi(w[q][j].y) * rs[q] * gg[j].w}, orow + 64 * j); }
        }
    }
}
constexpr int N_PHASES = 1 + DEPTH * 15;

extern "C" void kernel_launch(void* const* d_in, const int* in_sizes, int n_in, void* d_out, int out_size, void* d_ws, size_t ws_size, hipStream_t stream) {
    static int grid = 0;
    if (grid == 0) {
        if (n_in != 29 || out_size != M * D || ws_size < WS_NEED) { fprintf(stderr, "kernel_launch: unexpected problem (n_in %d, out %d, ws %zu)\n", n_in, out_size, ws_size); grid = -1; return; }
        int dev = 0, cus = 0, per_cu = 0;
        hipGetDevice(&dev);
        hipDeviceGetAttribute(&cus, hipDeviceAttributeMultiprocessorCount, dev);
        if (hipFuncSetAttribute((const void*)fwd_kernel, hipFuncAttributeMaxDynamicSharedMemorySize, LDS_BYTES) != hipSuccess) { fprintf(stderr, "kernel_launch: hipFuncSetAttribute failed\n"); grid = -1; return; }
        if (hipOccupancyMaxActiveBlocksPerMultiprocessor(&per_cu, (const void*)fwd_kernel, 512, LDS_BYTES) != hipSuccess || per_cu < 1) { fprintf(stderr, "kernel_launch: occupancy query gave %d\n", per_cu); per_cu = 1; }
        (void)hipGetLastError();
        grid = cus * per_cu;
    }
    if (grid < 0) return;
    if (hipMemsetAsync((char*)d_ws, 0, 262144, stream) != hipSuccess) { fprintf(stderr, "kernel_launch: memset failed\n"); return; }
    Args a{};
    for (int i = 0; i < 29; ++i) a.in[i] = (const float*)d_in[i];
    a.out = (float*)d_out; a.ws = (unsigned char*)d_ws; a.ph_lo = 0; a.ph_hi = N_PHASES;
    void* kargs[] = {&a};
    hipError_t e = hipLaunchCooperativeKernel((const void*)fwd_kernel, dim3(grid), dim3(512), kargs, LDS_BYTES, stream);
    if (e != hipSuccess) fprintf(stderr, "kernel_launch: cooperative launch failed: %s (grid %d)\n", hipGetErrorString(e), grid);
}
```
